# Optimizing an MI355X kernel written in HIP

```python
import jax, jax.numpy as jnp
from jax import lax
import numpy as np


D_MODEL = 1024
BATCH = 4
SEQ = 8192
DEPTH = 2
DEC_BATCH = 32
DEC_SEQ = 2048
PAST_LEN = 128

D_PLE = 256
D_CONV = D_MODEL // 2
D_RWKV = D_MODEL // 2
HEAD_SIZE = 64
N_HEADS = D_RWKV // HEAD_SIZE
LORA_W = 64
LORA_A = 64
LORA_G = 128
D_FF = 11 * D_MODEL // 4
NORM_EPS = 1e-6
GN_EPS = HEAD_SIZE * 1e-5
IN_SIZES = (D_CONV, D_CONV, D_CONV, D_RWKV, D_RWKV, D_RWKV,
            LORA_W + LORA_A, LORA_W + LORA_A, LORA_G, D_MODEL, D_MODEL)
IN_COLS = sum(IN_SIZES)

kernel_name = 'hybrid_bidir_conv_rwkv7_encoder'


def _rmsnorm(x, g):
    xf = x.astype(jnp.float32)
    y = xf * lax.rsqrt(jnp.mean(xf * xf, axis=-1, keepdims=True) + NORM_EPS)
    return (y * g.astype(jnp.float32)).astype(x.dtype)


def _split(z, sizes):
    idx = [int(s) for s in np.cumsum(sizes)[:-1]]
    return jnp.split(z, idx, axis=-1)


def _shift_prev(z):
    return jnp.pad(z, ((0, 0), (1, 0), (0, 0)))[:, :-1]


def _shift_next(z):
    return jnp.pad(z, ((0, 0), (0, 1), (0, 0)))[:, 1:]


def _conv3(x, w, b):
    xp = jnp.pad(x, ((0, 0), (1, 1), (0, 0)))
    return xp[:, :-2] * w[0] + xp[:, 1:-1] * w[1] + xp[:, 2:] * w[2] + b


def _wkv_scan(r, w, kk, b, k, v, reverse):
    bsz = r.shape[0]
    xs = tuple(jnp.moveaxis(t.astype(jnp.float32), 1, 0) for t in (r, w, kk, b, k, v))

    def step(S, inp):
        r_t, w_t, kk_t, b_t, k_t, v_t = inp
        sa = jnp.einsum('bhvk,bhk->bhv', S, kk_t)
        S = (S * w_t[:, :, None, :] - sa[..., None] * b_t[:, :, None, :]
             + v_t[..., None] * k_t[:, :, None, :])
        return S, jnp.einsum('bhvk,bhk->bhv', S, r_t)

    S0 = jnp.zeros((bsz, N_HEADS, HEAD_SIZE, HEAD_SIZE), jnp.float32)
    _, ys = lax.scan(step, S0, xs, reverse=reverse)
    return jnp.moveaxis(ys, 0, 1)


def _rwkv_branch(r, k, v, zf, zb, gd, shift_mu, decay_w0, decay_w2, iclr_a0, iclr_a2,
                 gate_g2, k_k, k_a, r_k, gn_w, gn_b, w_branch_b):
    bsz, T, _ = r.shape
    f32 = jnp.float32

    def heads(t):
        return t.reshape(bsz, T, N_HEADS, HEAD_SIZE)

    r32, k32, v32 = r.astype(f32), k.astype(f32), v.astype(f32)
    kk = heads(k32 * k_k)
    kk = kk / jnp.maximum(jnp.linalg.norm(kk, axis=-1, keepdims=True), 1e-12)
    outs = []
    for d, (z, z_shift, rev) in enumerate(((zf, _shift_prev(zf), False),
                                           (zb, _shift_next(zb), True))):
        z = (z + shift_mu[d] * (z_shift - z)).astype(f32)
        zw, za = z[..., :LORA_W], z[..., LORA_W:]
        logit = decay_w0[d] + jnp.tanh(zw) @ decay_w2[d]
        w = jnp.exp(-jnp.exp(-jax.nn.softplus(-logit) - 0.5))
        a = jax.nn.sigmoid(iclr_a0[d] + za @ iclr_a2[d])
        kd = k32 * (1.0 + (a - 1.0) * k_a)
        outs.append(_wkv_scan(heads(r32), heads(w), kk, kk * heads(a), heads(kd),
                              heads(v32), rev))
    y = outs[0] + outs[1]
    mean = jnp.mean(y, axis=-1, keepdims=True)
    var = jnp.mean(jnp.square(y - mean), axis=-1, keepdims=True)
    y = ((y - mean) * lax.rsqrt(var + GN_EPS)).reshape(bsz, T, D_RWKV) * gn_w + gn_b
    bonus = jnp.sum(heads(r32) * heads(k32) * r_k, axis=-1, keepdims=True) * heads(v32)
    g = jax.nn.sigmoid(gd.astype(f32)) @ gate_g2
    out = (y + bonus.reshape(bsz, T, D_RWKV)) * g
    return out.astype(r.dtype) @ w_branch_b


def _mixer(u, w_in, conv_w, conv_b, w_branch_a, shift_mu, decay_w0, decay_w2, iclr_a0,
           iclr_a2, gate_g2, k_k, k_a, r_k, gn_w, gn_b, w_branch_b, w_out):
    proj = u @ w_in
    (hc, b_gate, c_gate, r, k, v, zf, zb, gd,
     gate_conv, gate_rwkv) = _split(proj, IN_SIZES)
    y_conv = (b_gate * _conv3(c_gate * hc, conv_w, conv_b)) @ w_branch_a
    y_rwkv = _rwkv_branch(r, k, v, zf, zb, gd, shift_mu, decay_w0, decay_w2, iclr_a0,
                          iclr_a2, gate_g2, k_k, k_a, r_k, gn_w, gn_b, w_branch_b)
    merged = jax.nn.sigmoid(gate_conv) * y_conv + jax.nn.sigmoid(gate_rwkv) * y_rwkv
    return merged @ w_out


def _conv_ffn(u, w_up, ffn_conv_w, ffn_conv_b, w_down):
    h = _conv3(u @ w_up, ffn_conv_w, ffn_conv_b)
    hg, hv = jnp.split(h, 2, axis=-1)
    return (jax.nn.gelu(hg, approximate=True) * hv) @ w_down


def _layer(x, p, norm_mix_pre, norm_mix_post, norm_ffn_pre, norm_ffn_post, norm_ple_post,
           w_in, conv_w, conv_b, w_branch_a, shift_mu, decay_w0, decay_w2, iclr_a0, iclr_a2,
           gate_g2, k_k, k_a, r_k, gn_w, gn_b, w_branch_b, w_out, w_up, ffn_conv_w,
           ffn_conv_b, w_down, w_ple, w_ple_gate):
    u = _rmsnorm(x, norm_mix_pre)
    m = _mixer(u, w_in, conv_w, conv_b, w_branch_a, shift_mu, decay_w0, decay_w2, iclr_a0,
               iclr_a2, gate_g2, k_k, k_a, r_k, gn_w, gn_b, w_branch_b, w_out)
    x = x + _rmsnorm(m, norm_mix_post)
    f = _conv_ffn(_rmsnorm(x, norm_ffn_pre), w_up, ffn_conv_w, ffn_conv_b, w_down)
    x = x + _rmsnorm(f, norm_ffn_post)
    gate = jax.nn.sigmoid(x @ w_ple_gate)
    x = x + _rmsnorm(gate * (p @ w_ple), norm_ple_post)
    return x


def setup_inputs(seed: int = 0) -> dict:
    key = jax.random.key(seed)
    ks = iter(jax.random.split(key, 48))
    L = DEPTH

    def nrm(shape, scale):
        return scale * jax.random.normal(next(ks), shape, jnp.float32)

    def gain(shape):
        return 1.0 + nrm(shape, 0.05)

    return {
        'x_prompt': nrm((BATCH, SEQ, D_MODEL), 1.0),
        'x_sample': nrm((DEC_BATCH, DEC_SEQ, D_MODEL), 1.0),
        'p_prompt': nrm((DEPTH, BATCH, SEQ, D_PLE), 1.0),
        'p_sample': nrm((DEPTH, DEC_BATCH, DEC_SEQ, D_PLE), 1.0),
        'norm_mix_pre': gain((L, D_MODEL)),
        'norm_mix_post': gain((L, D_MODEL)),
        'norm_ffn_pre': gain((L, D_MODEL)),
        'norm_ffn_post': gain((L, D_MODEL)),
        'norm_ple_post': gain((L, D_MODEL)),
        'w_in': nrm((L, D_MODEL, IN_COLS), D_MODEL ** -0.5),
        'conv_w': nrm((L, 3, D_CONV), 3 ** -0.5),
        'conv_b': nrm((L, D_CONV), 0.02),
        'w_branch_a': nrm((L, D_CONV, D_MODEL), D_CONV ** -0.5),
        'shift_mu': jax.random.uniform(next(ks), (L, 2, LORA_W + LORA_A), jnp.float32, 0.2, 0.8),
        'decay_w0': -3.0 + nrm((L, 2, D_RWKV), 1.5),
        'decay_w2': nrm((L, 2, LORA_W, D_RWKV), 0.1),
        'iclr_a0': nrm((L, 2, D_RWKV), 0.5),
        'iclr_a2': nrm((L, 2, LORA_A, D_RWKV), LORA_A ** -0.5),
        'gate_g2': nrm((L, LORA_G, D_RWKV), LORA_G ** -0.5),
        'k_k': 0.85 + nrm((L, D_RWKV), 0.05),
        'k_a': 1.0 + nrm((L, D_RWKV), 0.05),
        'r_k': nrm((L, N_HEADS, HEAD_SIZE), 0.1),
        'gn_w': gain((L, D_RWKV)),
        'gn_b': nrm((L, D_RWKV), 0.02),
        'w_branch_b': nrm((L, D_RWKV, D_MODEL), D_RWKV ** -0.5),
        'w_out': nrm((L, D_MODEL, D_MODEL), D_MODEL ** -0.5),
        'w_up': nrm((L, D_MODEL, 2 * D_FF), D_MODEL ** -0.5),
        'ffn_conv_w': nrm((L, 3, 2 * D_FF), 3 ** -0.5),
        'ffn_conv_b': nrm((L, 2 * D_FF), 0.02),
        'w_down': nrm((L, D_FF, D_MODEL), D_FF ** -0.5),
        'w_ple': nrm((L, D_PLE, D_MODEL), D_PLE ** -0.5),
        'w_ple_gate': nrm((L, D_MODEL, D_MODEL), D_MODEL ** -0.5),
    }


def reference(x_prompt, x_sample, p_prompt, p_sample, norm_mix_pre, norm_mix_post,
              norm_ffn_pre, norm_ffn_post, norm_ple_post, w_in, conv_w, conv_b, w_branch_a,
              shift_mu, decay_w0, decay_w2, iclr_a0, iclr_a2, gate_g2, k_k, k_a, r_k, gn_w,
              gn_b, w_branch_b, w_out, w_up, ffn_conv_w, ffn_conv_b, w_down, w_ple,
              w_ple_gate):
    y_prompt, y_sample = x_prompt, x_sample
    for i in range(DEPTH):
        lp = dict(norm_mix_pre=norm_mix_pre[i], norm_mix_post=norm_mix_post[i],
                  norm_ffn_pre=norm_ffn_pre[i], norm_ffn_post=norm_ffn_post[i],
                  norm_ple_post=norm_ple_post[i], w_in=w_in[i], conv_w=conv_w[i],
                  conv_b=conv_b[i], w_branch_a=w_branch_a[i], shift_mu=shift_mu[i],
                  decay_w0=decay_w0[i], decay_w2=decay_w2[i], iclr_a0=iclr_a0[i],
                  iclr_a2=iclr_a2[i], gate_g2=gate_g2[i], k_k=k_k[i], k_a=k_a[i],
                  r_k=r_k[i], gn_w=gn_w[i], gn_b=gn_b[i], w_branch_b=w_branch_b[i],
                  w_out=w_out[i], w_up=w_up[i], ffn_conv_w=ffn_conv_w[i],
                  ffn_conv_b=ffn_conv_b[i], w_down=w_down[i], w_ple=w_ple[i],
                  w_ple_gate=w_ple_gate[i])
        y_prompt = _layer(y_prompt, p_prompt[i], **lp)
        y_sample = _layer(y_sample, p_sample[i], **lp)
    return (y_prompt, y_sample)
```

```cpp
#include <hip/hip_runtime.h>
#include <hip/hip_cooperative_groups.h>
#include <cstdio>
namespace cg = cooperative_groups;

#define LAS __attribute__((address_space(3)))
typedef unsigned short bf16_t;
typedef short bf16x8 __attribute__((ext_vector_type(8)));
typedef float f32x4 __attribute__((ext_vector_type(4)));

#ifndef ONE_LAUNCH
#define ONE_LAUNCH 1
#endif

constexpr int DM = 1024, TCH = 32768  , NCHUNK = 3, NLAYER = 2;
constexpr int INC = 5504, LDP = 5632  , DFF = 2816, DPLE = 256;
constexpr int C_HC = 0, C_BG = 512, C_CG = 1024, C_R = 1536, C_K = 2048, C_V = 2560, C_ZF = 3072, C_ZB = 3200, C_GD = 3328, C_GC = 3456, C_GR = 4480;
constexpr size_t W_IN = 0, W_A = 5767168, W_B = 6291456, W_OUT = 6815744, W_UP = 7864320, W_DOWN = 13631488, W_PLE = 16515072, W_PG = 16777216, W_LAYER = 17825792;
constexpr size_t MiB = 1048576;
constexpr size_t OFF_W = 0, OFF_U = 68 * MiB, OFF_P = 132 * MiB, OFF_M = 484 * MiB, OFF_S = 612 * MiB, OFF_LORA = 996 * MiB;
constexpr int LORA_N = 2560, LORA_K = 384; constexpr size_t LORA_ELEMS = (size_t)LORA_N * LORA_K;
constexpr size_t OFF_FS = 1000 * MiB;
constexpr size_t OFF_Y = OFF_S + 256 * MiB, OFF_XB = OFF_S + 320 * MiB;
constexpr size_t OFF_BAR = 1008 * MiB;
constexpr size_t OFF_GG = OFF_U, OFF_ZT = OFF_M + 96 * MiB;
constexpr int NPH = 1 + 29 + 2 * 27;
constexpr int SMEM_BYTES = 131072;

struct Params { const float* in[32]; float* out; unsigned char* ws; };
typedef const __attribute__((address_space(4))) Params* KP;

__device__ __forceinline__ bf16_t f2bf(float f) { unsigned u = __float_as_uint(f); u += 0x7FFFu + ((u >> 16) & 1u); return (bf16_t)(u >> 16); }
__device__ __forceinline__ float bf2f(unsigned b) { return __uint_as_float(b << 16); }
__device__ __forceinline__ unsigned pack2(float lo, float hi) { return (unsigned)f2bf(lo) | ((unsigned)f2bf(hi) << 16); }
__device__ __forceinline__ float bflo(unsigned u) { return __uint_as_float(u << 16); }
__device__ __forceinline__ float bfhi(unsigned u) { return __uint_as_float(u & 0xffff0000u); }
__device__ __forceinline__ float wave_sum(float v) {
#pragma unroll
    for (int o = 32; o > 0; o >>= 1) v += __shfl_xor(v, o, 64);
    return v;
}
__device__ __forceinline__ int o_tid() { int t = threadIdx.x; asm volatile("" : "+v"(t)); return t; }
__device__ __forceinline__ int o_bid() { int t = blockIdx.x; asm volatile("" : "+s"(t)); return t; }
__device__ __forceinline__ int o_nblk() { int t = gridDim.x; asm volatile("" : "+s"(t)); return t; }
__device__ __forceinline__ float sigmoidf_(float x) { return __builtin_amdgcn_rcpf(1.0f + __expf(-x)); }

__device__ __forceinline__ float dpp_xor1(float x) { return __int_as_float(__builtin_amdgcn_update_dpp(0, __float_as_int(x), 0xB1, 0xF, 0xF, true)); }
__device__ __forceinline__ float dpp_xor2(float x) { return __int_as_float(__builtin_amdgcn_update_dpp(0, __float_as_int(x), 0x4E, 0xF, 0xF, true)); }
__device__ __forceinline__ float dpp_hmirror(float x) { return __int_as_float(__builtin_amdgcn_update_dpp(0, __float_as_int(x), 0x141, 0xF, 0xF, true)); }
__device__ __forceinline__ float dpp_rmirror(float x) { return __int_as_float(__builtin_amdgcn_update_dpp(0, __float_as_int(x), 0x140, 0xF, 0xF, true)); }
__device__ __forceinline__ float sum16(float x) { x += dpp_xor1(x); x += dpp_xor2(x); x += dpp_hmirror(x); x += dpp_rmirror(x); return x; }
__device__ __forceinline__ float sum8(float x) { x += dpp_xor1(x); x += dpp_xor2(x); x += dpp_hmirror(x); return x; }
__device__ __forceinline__ void unpack8(const uint4 u, float (&f)[8]) { f[0] = bflo(u.x); f[1] = bfhi(u.x); f[2] = bflo(u.y); f[3] = bfhi(u.y); f[4] = bflo(u.z); f[5] = bfhi(u.z); f[6] = bflo(u.w); f[7] = bfhi(u.w); }
__device__ __forceinline__ uint4 pack8(const float (&f)[8]) { uint4 u; u.x = pack2(f[0], f[1]); u.y = pack2(f[2], f[3]); u.z = pack2(f[4], f[5]); u.w = pack2(f[6], f[7]); return u; }

namespace pg8 {
constexpr int BM = 256, BK = 64, HALF = 128, HTB = HALF * BK * 2, NXCD = 8, WGM = 8;
__device__ __forceinline__ int lds_byte(int r, int c) { const int st = (r >> 4) * 2 + (c >> 5), rr = r & 15, cc = c & 31, ob = rr * 64 + cc * 2; return st * 1024 + (ob ^ (((ob >> 9) & 1) << 5)); }
__device__ __forceinline__ void stage_rc(int b, int& R, int& C) { const int st = b / 1024, sb = b % 1024, swz = sb ^ (((sb >> 9) & 1) << 5); R = (st >> 1) * 16 + swz / 64; C = (st & 1) * 32 + (swz % 64) / 2; }
struct Unit { int pm, pn; };
struct Gemm { const bf16_t* A; const bf16_t* Bt; int lda, ldb, nM, N, K, ovl, perm; };
struct StaticOrder {
    int nM, nN, nwg, G, c;
    __device__ void init(int nM_, int N, int G_, int c_) { nM = nM_; nN = N / BM; nwg = nM * nN; G = G_; c = c_; }
    __device__ bool next(int i, Unit& u) const {
        const long L = (long)i * G + c; if (L >= nwg) return false;
        int wgid = (int)L; { const int q = nwg / NXCD, r = nwg % NXCD, xcd = wgid % NXCD, off = wgid / NXCD; wgid = (xcd < r ? xcd * (q + 1) : r * (q + 1) + (xcd - r) * q) + off; }
        const int nig = WGM * nN, gid = wgid / nig, fm = gid * WGM, gsz = (nM - fm) < WGM ? (nM - fm) : WGM;
        u.pm = fm + ((wgid % nig) % gsz); u.pn = (wgid % nig) / gsz; return true;
    }
};

template <class Epi>
__device__ __forceinline__ void gemm_phase(LAS unsigned char* lds, const Gemm g, const Epi& E) {
    const int tid = o_tid(), wid = __builtin_amdgcn_readfirstlane(tid >> 6), lane = tid & 63, wr = wid >> 2, wc = wid & 3, fr = lane & 15, fq = lane >> 4;
    const int K = g.K, nt = K / BK;
    StaticOrder S; S.init(g.nM, g.N, o_nblk(), o_bid());
    unsigned voffA[2], voffB[2];
#pragma unroll
    for (int i = 0; i < 2; ++i) { int R, C; stage_rc(tid * 16 + i * 8192, R, C); const int Ra = (g.ovl == 1) ? (R >> 6) * 62 + (R & 63) : R;
        const int Rb = g.perm ? ((R & ~31) + 8 * ((R & 15) >> 2) + 4 * ((R >> 4) & 1) + (R & 3)) : R;
        voffA[i] = (unsigned)(Ra * g.lda + C) * 2u; voffB[i] = (unsigned)(Rb * g.ldb + C) * 2u; }
    const size_t kstep = (size_t)(BK * 2);
    const size_t hstepA = (size_t)((g.ovl == 1) ? 124 : HALF) * g.lda * 2, hstepB = (size_t)HALF * g.ldb * 2;
    const size_t tstepA = 2 * hstepA, tstepB = 2 * hstepB;
    const unsigned ldsw = (unsigned)wid * 1024u;
    const int aoff = lds_byte(wr * 64 + fr, fq * 8), boff = lds_byte(wc * 32 + fr, fq * 8);
#define PG8_SA(b, h) (((b) * 2 + (h)) * HTB)
#define PG8_SB(b, h) ((4 + (b) * 2 + (h)) * HTB)
#define PG8_STAGE(bufoff, gbase, voff) do { _Pragma("unroll") for (int _i = 0; _i < 2; ++_i) \
        __builtin_amdgcn_global_load_lds((const unsigned*)((const char*)(gbase) + (voff)[_i]), (LAS unsigned*)(lds + (bufoff) + ldsw + _i * 8192), 16, 0, 0); } while (0)
#define PG8_LDA(dst, b, h) do { _Pragma("unroll") for (int m = 0; m < 4; ++m) _Pragma("unroll") for (int k = 0; k < 2; ++k) dst[m][k] = *(const LAS bf16x8*)(lds + PG8_SA(b, h) + aoff + m * 2048 + k * 1024); } while (0)
#define PG8_LDB(dst, b, h) do { _Pragma("unroll") for (int n = 0; n < 2; ++n) _Pragma("unroll") for (int k = 0; k < 2; ++k) dst[n][k] = *(const LAS bf16x8*)(lds + PG8_SB(b, h) + boff + n * 2048 + k * 1024); } while (0)
#define PG8_MMA(ai, bj, At, Bt) do { __builtin_amdgcn_s_setprio(1); _Pragma("unroll") for (int m = 0; m < 4; ++m) _Pragma("unroll") for (int n = 0; n < 2; ++n) _Pragma("unroll") for (int k = 0; k < 2; ++k) \
        acc[ai][bj][m][n] = __builtin_amdgcn_mfma_f32_16x16x32_bf16(Bt[n][k], At[m][k], acc[ai][bj][m][n], 0, 0, 0); __builtin_amdgcn_s_setprio(0); } while (0)
#define PG8_WAIT_V(n) asm volatile("s_waitcnt vmcnt(" #n ")" ::: "memory")
#define PG8_WAIT_L(n) asm volatile("s_waitcnt lgkmcnt(" #n ")" ::: "memory")
#define PG8_BAR __builtin_amdgcn_s_barrier()
#define PG8_SCHED __builtin_amdgcn_sched_barrier(0)
    const bool split = (g.ovl == 2); const size_t koff = (size_t)g.K * 2;
    Unit cur, nxt; int ui = 0, chalf = 0, nhalf = 0;
    if (!S.next(0, cur)) return;
    f32x4 acc[2][2][4][2];
#pragma unroll
    for (int a = 0; a < 2; ++a)
#pragma unroll
        for (int b = 0; b < 2; ++b)
#pragma unroll
            for (int m = 0; m < 4; ++m)
#pragma unroll
                for (int n = 0; n < 2; ++n) acc[a][b][m][n] = (f32x4){0.f, 0.f, 0.f, 0.f};
    bf16x8 At[4][2], B0[2][2], B1[2][2];
    const char* cA = (const char*)g.A + (size_t)cur.pm * tstepA; const char* cB = (const char*)g.Bt + (size_t)cur.pn * tstepB;
    PG8_STAGE(PG8_SB(0, 0), cB, voffB); PG8_STAGE(PG8_SA(0, 0), cA, voffA); PG8_STAGE(PG8_SB(0, 1), cB + hstepB, voffB); PG8_STAGE(PG8_SA(0, 1), cA + hstepA, voffA);
    if (wr == 1) PG8_BAR;
    PG8_WAIT_V(4); PG8_BAR;
    PG8_STAGE(PG8_SB(1, 0), cB + kstep, voffB); PG8_STAGE(PG8_SA(1, 0), cA + kstep, voffA); PG8_STAGE(PG8_SB(1, 1), cB + hstepB + kstep, voffB);
    PG8_WAIT_V(6); PG8_BAR;
    for (;;) {
        nhalf = split ? ((ui + 1) & 1) : 0;
        const bool has_next = S.next(split ? ((ui + 1) >> 1) : (ui + 1), nxt);
        const char* nA = has_next ? (const char*)g.A + (size_t)nxt.pm * tstepA + (nhalf ? koff : 0) : cA; const char* nB = has_next ? (const char*)g.Bt + (size_t)nxt.pn * tstepB + (nhalf ? koff : 0) : cB;
        for (int t = 0; t < nt; t += 2) {
            const bool last = (t == nt - 2);
            const char* a1 = cA + (size_t)(t + 1) * kstep;
            const char* a2 = last ? nA : cA + (size_t)(t + 2) * kstep; const char* b2 = last ? nB : cB + (size_t)(t + 2) * kstep;
            const char* a3 = a2 + kstep; const char* b3 = b2 + kstep;
            PG8_LDB(B0, 0, 0); PG8_SCHED; PG8_LDA(At, 0, 0); PG8_STAGE(PG8_SA(1, 1), a1 + hstepA, voffA);
            PG8_WAIT_L(8); PG8_BAR; PG8_WAIT_L(0); PG8_MMA(0, 0, At, B0); PG8_BAR; PG8_SCHED;
            PG8_LDB(B1, 0, 1); PG8_STAGE(PG8_SB(0, 0), b2, voffB);
            PG8_BAR; PG8_WAIT_L(0); PG8_MMA(0, 1, At, B1); PG8_BAR;
            PG8_LDA(At, 0, 1); PG8_STAGE(PG8_SA(0, 0), a2, voffA);
            PG8_BAR; PG8_WAIT_L(0); PG8_MMA(1, 0, At, B0); PG8_BAR; PG8_SCHED;
            PG8_STAGE(PG8_SB(0, 1), b2 + hstepB, voffB);
            PG8_WAIT_V(6); PG8_BAR; PG8_MMA(1, 1, At, B1); PG8_BAR;
            PG8_LDB(B0, 1, 0); PG8_SCHED; PG8_LDA(At, 1, 0); PG8_STAGE(PG8_SA(0, 1), a2 + hstepA, voffA);
            PG8_WAIT_L(8); PG8_BAR; PG8_WAIT_L(0); PG8_MMA(0, 0, At, B0); PG8_BAR; PG8_SCHED;
            PG8_LDB(B1, 1, 1); PG8_STAGE(PG8_SB(1, 0), b3, voffB);
            PG8_BAR; PG8_WAIT_L(0); PG8_MMA(0, 1, At, B1); PG8_BAR;
            PG8_LDA(At, 1, 1); PG8_STAGE(PG8_SA(1, 0), a3, voffA);
            PG8_BAR; PG8_WAIT_L(0); PG8_MMA(1, 0, At, B0); PG8_BAR; PG8_SCHED;
            PG8_STAGE(PG8_SB(1, 1), b3 + hstepB, voffB);
            PG8_WAIT_V(6); PG8_BAR; PG8_MMA(1, 1, At, B1); PG8_BAR;
        }
        const bool is_mid = split && (chalf == 0);
        if (is_mid) E.mid(acc, cur, wr, wc, fr, fq); else E(acc, cur, wr, wc, fr, fq);
        if (!has_next) break;
        if (!is_mid)
#pragma unroll
        for (int a = 0; a < 2; ++a)
#pragma unroll
            for (int b = 0; b < 2; ++b)
#pragma unroll
                for (int m = 0; m < 4; ++m)
#pragma unroll
                    for (int n = 0; n < 2; ++n) acc[a][b][m][n] = (f32x4){0.f, 0.f, 0.f, 0.f};
        cur = nxt; cA = nA; cB = nB; ++ui; chalf = nhalf;
    }
    PG8_WAIT_V(0);
    if (wr == 0) PG8_BAR;
    PG8_BAR;
#undef PG8_SA
#undef PG8_SB
#undef PG8_STAGE
#undef PG8_LDA
#undef PG8_LDB
#undef PG8_MMA
#undef PG8_WAIT_V
#undef PG8_WAIT_L
#undef PG8_BAR
#undef PG8_SCHED
}

#define EPI_ROWS(...) \
    const int row0 = u.pm * BM + wr * 64 + fr, col0 = u.pn * BM + wc * 32 + 4 * fq; \
    _Pragma("unroll") for (int ai = 0; ai < 2; ++ai) _Pragma("unroll") for (int m = 0; m < 4; ++m) { const size_t row = (size_t)(row0 + ai * HALF + m * 16); __VA_ARGS__ }
#define EPI_COLS(...) \
    _Pragma("unroll") for (int bj = 0; bj < 2; ++bj) _Pragma("unroll") for (int n = 0; n < 2; ++n) { const int co = bj * HALF + n * 16; const f32x4 v = acc[ai][bj][m][n]; __VA_ARGS__ }

struct EpiBf16 {
    bf16_t* O; int ldc;
    __device__ __forceinline__ void operator()(const f32x4 (&acc)[2][2][4][2], const Unit& u, int wr, int wc, int fr, int fq) const {
        EPI_ROWS( bf16_t* rowp = O + row * ldc + col0;
            EPI_COLS( uint2 o; o.x = pack2(v[0], v[1]); o.y = pack2(v[2], v[3]); *(uint2*)(rowp + co) = o; ) )
    }
};
struct EpiF32 {
    float* C; int ldc;
    __device__ __forceinline__ void operator()(const f32x4 (&acc)[2][2][4][2], const Unit& u, int wr, int wc, int fr, int fq) const {
        EPI_ROWS( float* rowp = C + row * ldc + col0;
            EPI_COLS( *(f32x4*)(rowp + co) = v; ) )
    }
};
struct EpiGate2 {
    bf16_t* O; const bf16_t* gate;
    __device__ __forceinline__ void mid(f32x4 (&acc)[2][2][4][2], const Unit& u, int wr, int wc, int fr, int fq) const {
        EPI_ROWS( const bf16_t* gp = gate + row * LDP + col0;
            _Pragma("unroll") for (int bj = 0; bj < 2; ++bj) _Pragma("unroll") for (int n = 0; n < 2; ++n) { const int co = bj * HALF + n * 16;
                const uint2 gcq = *(const uint2*)(gp + C_GC + co), grq = *(const uint2*)(gp + C_GR + co);
                const float gc[4] = {bflo(gcq.x), bfhi(gcq.x), bflo(gcq.y), bfhi(gcq.y)}, gr[4] = {bflo(grq.x), bfhi(grq.x), bflo(grq.y), bfhi(grq.y)};
                _Pragma("unroll") for (int e = 0; e < 4; ++e) acc[ai][bj][m][n][e] *= sigmoidf_(gc[e]) * (1.0f + __expf(-fminf(fmaxf(gr[e], -30.f), 30.f))); } )
    }
    __device__ __forceinline__ void operator()(const f32x4 (&acc)[2][2][4][2], const Unit& u, int wr, int wc, int fr, int fq) const {
        EPI_ROWS( bf16_t* rowp = O + row * DM + col0; const bf16_t* gp = gate + row * LDP + C_GR + col0;
            EPI_COLS( const uint2 grq = *(const uint2*)(gp + co);
                const float r0 = sigmoidf_(fminf(fmaxf(bflo(grq.x), -30.f), 30.f)) * v[0], r1 = sigmoidf_(fminf(fmaxf(bfhi(grq.x), -30.f), 30.f)) * v[1];
                const float r2 = sigmoidf_(fminf(fmaxf(bflo(grq.y), -30.f), 30.f)) * v[2], r3 = sigmoidf_(fminf(fmaxf(bfhi(grq.y), -30.f), 30.f)) * v[3];
                uint2 o; o.x = pack2(r0, r1); o.y = pack2(r2, r3); *(uint2*)(rowp + co) = o; ) )
    }
};
struct EpiSigMul {
    bf16_t* O; const bf16_t* pp;
    __device__ __forceinline__ void operator()(const f32x4 (&acc)[2][2][4][2], const Unit& u, int wr, int wc, int fr, int fq) const {
        EPI_ROWS( bf16_t* rowp = O + row * DM + col0; const bf16_t* qp = pp + row * DM + col0;
            EPI_COLS( const uint2 pq = *(const uint2*)(qp + co);
                uint2 o; o.x = pack2(sigmoidf_(v[0]) * bflo(pq.x), sigmoidf_(v[1]) * bfhi(pq.x)); o.y = pack2(sigmoidf_(v[2]) * bflo(pq.y), sigmoidf_(v[3]) * bfhi(pq.y));
                *(uint2*)(rowp + co) = o; ) )
    }
};
__device__ __forceinline__ float dppf(float old, float src, const int ctrl_sel) {
    const int o = __float_as_int(old), x = __float_as_int(src); int r;
    if (ctrl_sel == 0) r = __builtin_amdgcn_update_dpp(o, x, 0x111, 0xF, 0xF, false);
    else if (ctrl_sel == 1) r = __builtin_amdgcn_update_dpp(o, x, 0x101, 0xF, 0xF, false);
    else if (ctrl_sel == 2) r = __builtin_amdgcn_update_dpp(o, x, 0x121, 0xF, 0xF, false);
    else r = __builtin_amdgcn_update_dpp(o, x, 0x12F, 0xF, 0xF, false);
    return __int_as_float(r);
}
struct EpiFfn {
    KP kp; int l, L;
    __device__ __forceinline__ void operator()(const f32x4 (&acc)[2][2][4][2], const Unit& u, int wr, int wc, int fr, int fq) const {
        unsigned char* ws = kp->ws;
        const float* cw = kp->in[27] + (size_t)l * 3 * 5632; const float* cb = kp->in[28] + (size_t)l * 5632;
#pragma unroll
        for (int bj = 0; bj < 2; ++bj) { const int J = u.pn * 128 + bj * 64 + wc * 16 + 4 * fq;
            const f32x4 wg0 = *(const f32x4*)(cw + J), wg1 = *(const f32x4*)(cw + 5632 + J), wg2 = *(const f32x4*)(cw + 11264 + J), bgv = *(const f32x4*)(cb + J);
            const f32x4 wv0 = *(const f32x4*)(cw + DFF + J), wv1 = *(const f32x4*)(cw + 5632 + DFF + J), wv2 = *(const f32x4*)(cw + 11264 + DFF + J), bvv = *(const f32x4*)(cb + DFF + J);
#pragma unroll
            for (int ai = 0; ai < 2; ++ai) { const int tb = u.pm * 248 + 62 * (ai * 2 + wr) - 1;
#pragma unroll
                for (int m = 0; m < 4; ++m) { const int r = 16 * m + fr, t = tb + r, pos = t & (L - 1);
                    const bool hp = pos != 0, hn = pos != L - 1, valid = (r >= 1) & (r <= 62) & (t < TCH);
                    float out[4];
#pragma unroll
                    for (int e = 0; e < 4; ++e) {
                        const float xg = acc[ai][bj][m][0][e], xv = acc[ai][bj][m][1][e];
                        float pg = dppf(m > 0 ? dppf(0.f, acc[ai][bj][m > 0 ? m - 1 : 0][0][e], 2) : 0.f, xg, 0);
                        float ng = dppf(m < 3 ? dppf(0.f, acc[ai][bj][m < 3 ? m + 1 : 3][0][e], 3) : 0.f, xg, 1);
                        float pv = dppf(m > 0 ? dppf(0.f, acc[ai][bj][m > 0 ? m - 1 : 0][1][e], 2) : 0.f, xv, 0);
                        float nv = dppf(m < 3 ? dppf(0.f, acc[ai][bj][m < 3 ? m + 1 : 3][1][e], 3) : 0.f, xv, 1);
                        if (!hp) { pg = 0.f; pv = 0.f; }
                        if (!hn) { ng = 0.f; nv = 0.f; }
                        const float hg = wg0[e] * pg + wg1[e] * xg + wg2[e] * ng + bgv[e], hv = wv0[e] * pv + wv1[e] * xv + wv2[e] * nv + bvv[e];
                        out[e] = hg * sigmoidf_(1.5957691216f * (hg + 0.044715f * hg * hg * hg)) * hv; }
                    if (valid) { uint2 o; o.x = pack2(out[0], out[1]); o.y = pack2(out[2], out[3]); *(uint2*)(ws + (unsigned)OFF_S + ((unsigned)t * (unsigned)DFF + (unsigned)J) * 2u) = o; }
                    __builtin_amdgcn_sched_barrier(0); } } }
    }
};
#define EPIP_ROWS(...) \
    const int row0 = u.pm * BM + wr * 64 + fr, col8 = u.pn * BM + wc * 32 + 8 * fq; \
    _Pragma("unroll") for (int ai = 0; ai < 2; ++ai) _Pragma("unroll") for (int m = 0; m < 4; ++m) { const size_t row = (size_t)(row0 + ai * HALF + m * 16); \
    _Pragma("unroll") for (int bj = 0; bj < 2; ++bj) { const int co = bj * HALF; const f32x4 v0 = acc[ai][bj][m][0], v1 = acc[ai][bj][m][1]; __VA_ARGS__ } }
struct EpiBf16P {
    bf16_t* O; int ldc;
    __device__ __forceinline__ void operator()(const f32x4 (&acc)[2][2][4][2], const Unit& u, int wr, int wc, int fr, int fq) const {
        EPIP_ROWS( uint4 o; o.x = pack2(v0[0], v0[1]); o.y = pack2(v0[2], v0[3]); o.z = pack2(v1[0], v1[1]); o.w = pack2(v1[2], v1[3]); *(uint4*)(O + row * ldc + col8 + co) = o; )
    }
};
struct EpiGate2P {
    bf16_t* O; const bf16_t* gate;
    __device__ __forceinline__ void mid(f32x4 (&acc)[2][2][4][2], const Unit& u, int wr, int wc, int fr, int fq) const {
        const int row0 = u.pm * BM + wr * 64 + fr, col8 = u.pn * BM + wc * 32 + 8 * fq;
#pragma unroll
        for (int ai = 0; ai < 2; ++ai)
#pragma unroll
            for (int m = 0; m < 4; ++m) { const bf16_t* gp = gate + (size_t)(row0 + ai * HALF + m * 16) * LDP + col8;
#pragma unroll
                for (int bj = 0; bj < 2; ++bj) { float gc[8], gr[8]; unpack8(*(const uint4*)(gp + C_GC + bj * HALF), gc); unpack8(*(const uint4*)(gp + C_GR + bj * HALF), gr);
#pragma unroll
                    for (int e = 0; e < 4; ++e) { acc[ai][bj][m][0][e] *= sigmoidf_(gc[e]) * (1.0f + __expf(-fminf(fmaxf(gr[e], -30.f), 30.f)));
                        acc[ai][bj][m][1][e] *= sigmoidf_(gc[4 + e]) * (1.0f + __expf(-fminf(fmaxf(gr[4 + e], -30.f), 30.f))); } } }
    }
    __device__ __forceinline__ void operator()(const f32x4 (&acc)[2][2][4][2], const Unit& u, int wr, int wc, int fr, int fq) const {
        EPIP_ROWS( float gr[8]; unpack8(*(const uint4*)(gate + row * LDP + C_GR + col8 + co), gr); float o[8];
            _Pragma("unroll") for (int e = 0; e < 4; ++e) { o[e] = sigmoidf_(fminf(fmaxf(gr[e], -30.f), 30.f)) * v0[e]; o[4 + e] = sigmoidf_(fminf(fmaxf(gr[4 + e], -30.f), 30.f)) * v1[e]; }
            *(uint4*)(O + row * DM + col8 + co) = pack8(o); )
    }
};
struct EpiSigMulP {
    bf16_t* O; const bf16_t* pp;
    __device__ __forceinline__ void operator()(const f32x4 (&acc)[2][2][4][2], const Unit& u, int wr, int wc, int fr, int fq) const {
        EPIP_ROWS( float pq[8]; unpack8(*(const uint4*)(pp + row * DM + col8 + co), pq); float o[8];
            _Pragma("unroll") for (int e = 0; e < 4; ++e) { o[e] = sigmoidf_(v0[e]) * pq[e]; o[4 + e] = sigmoidf_(v1[e]) * pq[4 + e]; }
            *(uint4*)(O + row * DM + col8 + co) = pack8(o); )
    }
};
struct EpiLora {
    KP kp; int l;
    __device__ __forceinline__ void operator()(const f32x4 (&acc)[2][2][4][2], const Unit& u, int wr, int wc, int fr, int fq) const {
        unsigned char* ws = kp->ws;
        if (u.pn >= 8) { EpiBf16P e{(bf16_t*)(ws + OFF_GG) - 2048, 512}; e(acc, u, wr, wc, fr, fq); return; }
        const int d = u.pn >> 2; const unsigned c = (unsigned)(128 * (u.pn & 3) + wc * 32 + 8 * fq);
        const float* w0p = kp->in[14] + (size_t)(l * 2 + d) * 512 + c; const float* a0p = kp->in[16] + (size_t)(l * 2 + d) * 512 + c;
        const f32x4 w0a = *(const f32x4*)(w0p), w0b = *(const f32x4*)(w0p + 4), a0a = *(const f32x4*)(a0p), a0b = *(const f32x4*)(a0p + 4);
        const unsigned row0 = (unsigned)(u.pm * BM + wr * 64 + fr);
#pragma unroll
        for (int ai = 0; ai < 2; ++ai)
#pragma unroll
            for (int m = 0; m < 4; ++m) { const unsigned row = row0 + (unsigned)(ai * HALF + m * 16);
                const f32x4 l0 = acc[ai][0][m][0] + w0a, l1 = acc[ai][0][m][1] + w0b, p0 = acc[ai][1][m][0] + a0a, p1 = acc[ai][1][m][1] + a0b;
                const unsigned d2 = (((unsigned)d * TCH + row) * 512u + c) * 2u;
                uint4 o; o.x = pack2(l0[0], l0[1]); o.y = pack2(l0[2], l0[3]); o.z = pack2(l1[0], l1[1]); o.w = pack2(l1[2], l1[3]); *(uint4*)(ws + (unsigned)OFF_S + d2) = o;
                o.x = pack2(p0[0], p0[1]); o.y = pack2(p0[2], p0[3]); o.z = pack2(p1[0], p1[1]); o.w = pack2(p1[2], p1[3]); *(uint4*)(ws + (unsigned)(OFF_S + 128 * MiB) + d2) = o; }
    }
};
struct EpiAny {
    KP kp; int s, l, L;
    __device__ __forceinline__ bool has_mid() const { return s == 6; }
    __device__ __forceinline__ void mid(f32x4 (&acc)[2][2][4][2], const Unit& u, int wr, int wc, int fr, int fq) const {
        unsigned char* ws = kp->ws; EpiGate2P e{(bf16_t*)(ws + OFF_U), (const bf16_t*)(ws + OFF_P)}; e.mid(acc, u, wr, wc, fr, fq); }
    __device__ __forceinline__ void operator()(const f32x4 (&acc)[2][2][4][2], const Unit& u, int wr, int wc, int fr, int fq) const {
        unsigned char* ws = kp->ws;
        bf16_t* RU = (bf16_t*)(ws + OFF_U); bf16_t* RP = (bf16_t*)(ws + OFF_P); bf16_t* MF = (bf16_t*)(ws + OFF_M);
        if (s == 1) { EpiBf16P e{RP, LDP}; e(acc, u, wr, wc, fr, fq); }
        else if (s == 10) { EpiFfn e{kp, l, L}; e(acc, u, wr, wc, fr, fq); }
        else if (s == 3) { EpiLora e{kp, l}; e(acc, u, wr, wc, fr, fq); }
        else if (s == 6) { EpiGate2P e{RU, RP}; e(acc, u, wr, wc, fr, fq); }
        else if (s == 8 || s == 12) { EpiBf16P e{MF, DM}; e(acc, u, wr, wc, fr, fq); }
        else if (s == 14) { EpiBf16P e{(bf16_t*)(ws + OFF_S + 192 * MiB), DM}; e(acc, u, wr, wc, fr, fq); }
        else { EpiSigMulP e{MF, (const bf16_t*)(ws + OFF_S + 192 * MiB)}; e(acc, u, wr, wc, fr, fq); }
    }
};
}

__device__ void phase_weights(KP p, float* tile  ) {
    bf16_t* wb = (bf16_t*)(p->ws + OFF_W);
    const int tid = o_tid(), bid = o_bid(), nblk = o_nblk();
    const int grp = tid >> 7, t128 = tid & 127, i2 = t128 >> 6, j = t128 & 63, nn = t128 >> 1, kh = (t128 & 1) * 32;
    float* tg = tile + grp * 4160;
    constexpr int TPL = 4352;
    for (int tb = bid * 4; tb < NLAYER * TPL; tb += nblk * 4) {
        const int gt = tb + grp; const bool act = gt < NLAYER * TPL;
        const int l = gt / TPL; int t = gt % TPL;
        const float* src; bf16_t* dst = wb + (size_t)l * W_LAYER; int K, N, ldd = 0; bool perm_up = false;
        if (t < 1408) { src = p->in[9] + (size_t)l * 1024 * INC; dst += W_IN; K = 1024; N = INC; }
        else if ((t -= 1408) < 128) { src = p->in[12] + (size_t)l * 512 * 1024; dst += W_A; K = 512; N = 1024; ldd = 1024; }
        else if ((t -= 128) < 128) { src = p->in[24] + (size_t)l * 512 * 1024; dst += W_A + 512; K = 512; N = 1024; ldd = 1024; }
        else if ((t -= 128) < 256) { src = p->in[25] + (size_t)l * 1024 * 1024; dst += W_OUT; K = 1024; N = 1024; }
        else if ((t -= 256) < 1408) { src = p->in[26] + (size_t)l * 1024 * 5632; dst += W_UP; K = 1024; N = 5632; perm_up = true; }
        else if ((t -= 1408) < 704) { src = p->in[29] + (size_t)l * DFF * 1024; dst += W_DOWN; K = DFF; N = 1024; }
        else if ((t -= 704) < 64) { src = p->in[30] + (size_t)l * DPLE * 1024; dst += W_PLE; K = DPLE; N = 1024; }
        else { t -= 64; src = p->in[31] + (size_t)l * 1024 * 1024; dst += W_PG; K = 1024; N = 1024; }
        const int tk = K / 64; if (ldd == 0) ldd = K;
        const int k0 = (t % tk) * 64, n0 = (t / tk) * 64, X = n0 + j;
        const int sc = perm_up ? ((X >> 4) & 1) * DFF + 128 * (X >> 8) + 64 * ((X >> 7) & 1) + 16 * ((X >> 5) & 3) + (X & 15) : X;
        float v[32];
        if (act) {
#pragma unroll
            for (int rr = 0; rr < 32; ++rr) v[rr] = (X < N) ? src[(size_t)(k0 + rr * 2 + i2) * N + sc] : 0.f;
        }
        __syncthreads();
        if (act) {
#pragma unroll
            for (int rr = 0; rr < 32; ++rr) tg[(rr * 2 + i2) * 65 + j] = v[rr];
        }
        __syncthreads();
        if (act) {
#pragma unroll
            for (int q = 0; q < 4; ++q) { float o[8];
#pragma unroll
                for (int e = 0; e < 8; ++e) o[e] = tg[(kh + 8 * q + e) * 65 + nn];
                *(uint4*)(dst + (size_t)(n0 + nn) * ldd + k0 + kh + 8 * q) = pack8(o); }
        }
    }
    __syncthreads();
    {
        bf16_t* LW = (bf16_t*)(p->ws + OFF_LORA);
        const float* dw2 = p->in[15]; const float* ia2 = p->in[17]; const float* gg2 = p->in[18];
        const int tid = o_tid(), bid = o_bid(), nblk = o_nblk();
        for (int idx = bid * 512 + tid; idx < NLAYER * (int)LORA_ELEMS; idx += nblk * 512) {
            const int l = idx / (int)LORA_ELEMS, rem = idx % (int)LORA_ELEMS, X = rem / LORA_K, k = rem % LORA_K, pn = X >> 8; float val = 0.f;
            if (pn < 8) { const int d = pn >> 2, n = (X >> 7) & 1, c = 128 * (pn & 3) + (X & 127), kk_ = k - 128 * d - 64 * n;
                if (kk_ >= 0 && kk_ < 64) val = n ? ia2[((size_t)(l * 2 + d) * 64 + kk_) * 512 + c] : dw2[((size_t)(l * 2 + d) * 64 + kk_) * 512 + c]; }
            else { const int cgc = X - 2048, kk_ = k - 256; if (kk_ >= 0) val = gg2[((size_t)l * 128 + kk_) * 512 + cgc]; }
            LW[idx] = f2bf(val);
        }
    }
}

__device__ void phase_rows(int flags, const float* xin, bf16_t* XB, const bf16_t* mf, const float* g1, const float* g2, float* xout, bf16_t* U,
                           const float* pin, bf16_t* Pb) {
    const int tid = o_tid(), wave = tid >> 6, lane = tid & 63; const int bid = o_bid(), nblk = o_nblk();
    const int stride = nblk * 8;
    for (int r0 = bid * 8 + wave; r0 < TCH; r0 += 2 * stride) {
        float4 x[2][4]; uint2 mq[2][4]; float4 pv[2];
#pragma unroll
        for (int k = 0; k < 2; ++k) { const int r = r0 + k * stride; if (r < TCH) {
            if (flags & 16) { const uint2* xr = (const uint2*)(XB + (size_t)r * DM);
#pragma unroll
                for (int i = 0; i < 4; ++i) { const uint2 q = xr[lane + 64 * i]; x[k][i] = make_float4(bflo(q.x), bfhi(q.x), bflo(q.y), bfhi(q.y)); } }
            else { const float4* xr = (const float4*)(xin + (size_t)r * DM);
#pragma unroll
                for (int i = 0; i < 4; ++i) x[k][i] = xr[lane + 64 * i]; }
            if (flags & 1) { const uint2* mr = (const uint2*)(mf + (size_t)r * DM);
#pragma unroll
                for (int i = 0; i < 4; ++i) mq[k][i] = mr[lane + 64 * i]; }
            if (flags & 8) pv[k] = ((const float4*)(pin + (size_t)r * DPLE))[lane]; } }
#pragma unroll
        for (int k = 0; k < 2; ++k) { const int r = r0 + k * stride; if (r < TCH) {
            if (flags & 1) {
                float ss = 0.f; float4 m[4];
#pragma unroll
                for (int i = 0; i < 4; ++i) { m[i] = make_float4(bflo(mq[k][i].x), bfhi(mq[k][i].x), bflo(mq[k][i].y), bfhi(mq[k][i].y)); ss += m[i].x * m[i].x + m[i].y * m[i].y + m[i].z * m[i].z + m[i].w * m[i].w; }
                ss = wave_sum(ss); const float rs = rsqrtf(ss * (1.0f / DM) + 1e-6f);
#pragma unroll
                for (int i = 0; i < 4; ++i) { const float4 g = ((const float4*)g1)[lane + 64 * i];
                    x[k][i].x += m[i].x * rs * g.x; x[k][i].y += m[i].y * rs * g.y; x[k][i].z += m[i].z * rs * g.z; x[k][i].w += m[i].w * rs * g.w; }
                if (flags & 32) { float4* xo = (float4*)(xout + (size_t)r * DM);
#pragma unroll
                    for (int i = 0; i < 4; ++i) xo[lane + 64 * i] = x[k][i]; }
                else { uint2* xo = (uint2*)(XB + (size_t)r * DM);
#pragma unroll
                    for (int i = 0; i < 4; ++i) { uint2 o; o.x = pack2(x[k][i].x, x[k][i].y); o.y = pack2(x[k][i].z, x[k][i].w); xo[lane + 64 * i] = o; } }
            }
            if (flags & 8) { uint2 o; o.x = pack2(pv[k].x, pv[k].y); o.y = pack2(pv[k].z, pv[k].w); ((uint2*)(Pb + (size_t)r * DPLE))[lane] = o; }
            if (flags & 2) {
                float ss = 0.f;
#pragma unroll
                for (int i = 0; i < 4; ++i) ss += x[k][i].x * x[k][i].x + x[k][i].y * x[k][i].y + x[k][i].z * x[k][i].z + x[k][i].w * x[k][i].w;
                ss = wave_sum(ss); const float rs2 = rsqrtf(ss * (1.0f / DM) + 1e-6f);
                uint2* uo = (uint2*)(U + (size_t)r * DM);
#pragma unroll
                for (int i = 0; i < 4; ++i) { const float4 g = ((const float4*)g2)[lane + 64 * i];
                    uint2 o; o.x = pack2(x[k][i].x * rs2 * g.x, x[k][i].y * rs2 * g.y); o.y = pack2(x[k][i].z * rs2 * g.z, x[k][i].w * rs2 * g.w); uo[lane + 64 * i] = o; }
            } } }
    }
}

__device__ void phase_prep_ew(KP p, int l, int L, const bf16_t* __restrict__ PROJ, bf16_t* __restrict__ G, bf16_t* KK, bf16_t* __restrict__ ZT) {
    const int tid = o_tid(), wave = tid >> 6, lane = tid & 63; const int bid = o_bid(), nblk = o_nblk();
    const int c8 = lane * 8, j2 = lane * 2;
    const float* conv_w = p->in[10] + (size_t)l * 1536; const float* conv_b = p->in[11] + (size_t)l * 512;
    const float* shift_mu = p->in[13] + (size_t)l * 256; const float* k_k = p->in[19] + (size_t)l * 512;
    float cw0[8], cw1[8], cw2[8], cb[8], kkc[8];
#pragma unroll
    for (int e = 0; e < 8; ++e) { cw0[e] = conv_w[c8 + e]; cw1[e] = conv_w[512 + c8 + e]; cw2[e] = conv_w[1024 + c8 + e]; cb[e] = conv_b[c8 + e]; kkc[e] = k_k[c8 + e]; }
    const float muf0 = shift_mu[j2], muf1 = shift_mu[j2 + 1], mub0 = shift_mu[128 + j2], mub1 = shift_mu[128 + j2 + 1];
#pragma unroll 2
    for (int r = bid * 8 + wave; r < TCH; r += nblk * 8) {
        const int pos = r & (L - 1); const bool hp = pos > 0, hn = pos < L - 1;
        const bf16_t* pr = PROJ + (size_t)r * LDP;
        const uint4 z4 = make_uint4(0, 0, 0, 0);
        const uint4 hc_c = *(const uint4*)(pr + C_HC + c8), cg_c = *(const uint4*)(pr + C_CG + c8), bgq = *(const uint4*)(pr + C_BG + c8), kq = *(const uint4*)(pr + C_K + c8);
        uint4 hc_p = z4, cg_p = z4, hc_n = z4, cg_n = z4; unsigned zf_p = 0, zb_n = 0;
        const unsigned zf_c = *(const unsigned*)(pr + C_ZF + j2), zb_c = *(const unsigned*)(pr + C_ZB + j2), gd_c = *(const unsigned*)(pr + C_GD + j2);
        if (hp) { hc_p = *(const uint4*)(pr - LDP + C_HC + c8); cg_p = *(const uint4*)(pr - LDP + C_CG + c8); zf_p = *(const unsigned*)(pr - LDP + C_ZF + j2); }
        if (hn) { hc_n = *(const uint4*)(pr + LDP + C_HC + c8); cg_n = *(const uint4*)(pr + LDP + C_CG + c8); zb_n = *(const unsigned*)(pr + LDP + C_ZB + j2); }
        float a[8], b[8], chp[8], chc[8], chn[8], o[8];
        unpack8(hc_p, a); unpack8(cg_p, b);
#pragma unroll
        for (int e = 0; e < 8; ++e) chp[e] = a[e] * b[e];
        unpack8(hc_c, a); unpack8(cg_c, b);
#pragma unroll
        for (int e = 0; e < 8; ++e) chc[e] = a[e] * b[e];
        unpack8(hc_n, a); unpack8(cg_n, b);
#pragma unroll
        for (int e = 0; e < 8; ++e) chn[e] = a[e] * b[e];
        unpack8(bgq, a);
#pragma unroll
        for (int e = 0; e < 8; ++e) o[e] = a[e] * (cw0[e] * chp[e] + cw1[e] * chc[e] + cw2[e] * chn[e] + cb[e]);
        *(uint4*)(G + (size_t)r * 1024 + c8) = pack8(o);
        { float m0 = bflo(zf_c), m1 = bfhi(zf_c); m0 += muf0 * (bflo(zf_p) - m0); m1 += muf1 * (bfhi(zf_p) - m1);
          if (lane < 32) { m0 = tanhf(m0); m1 = tanhf(m1); }
          float n0 = bflo(zb_c), n1 = bfhi(zb_c); n0 += mub0 * (bflo(zb_n) - n0); n1 += mub1 * (bfhi(zb_n) - n1);
          if (lane < 32) { n0 = tanhf(n0); n1 = tanhf(n1); }
          bf16_t* zr = ZT + (size_t)r * LORA_K;
          *(unsigned*)(zr + j2) = pack2(m0, m1); *(unsigned*)(zr + 128 + j2) = pack2(n0, n1);
          *(unsigned*)(zr + 256 + j2) = pack2(sigmoidf_(bflo(gd_c)), sigmoidf_(bfhi(gd_c))); }
    }
}

typedef float f32x2 __attribute__((ext_vector_type(2)));
struct ScanOps { f32x4 w[2], kk[2]; f32x2 v; };
__device__ __forceinline__ void scan_ld(const float* ob, const float* obv, int i, ScanOps& o) {
    const float* oi = ob + i * 64;
#pragma unroll
    for (int j4 = 0; j4 < 2; ++j4) { o.kk[j4] = *(const f32x4*)(oi + 1024 + 4 * j4); o.w[j4] = *(const f32x4*)(oi + 4 * j4); }
    o.v = *(const f32x2*)(obv + i * 64);
}
__device__ __forceinline__ void scan_rows(f32x2 (&X)[8], const ScanOps& o, const f32x4 (&b)[2], const f32x4 (&kd)[2], const f32x4 (&r)[2], const bool use_v, float& yA, float& yB) {
    f32x2 aA = X[0] * o.kk[0].xy, aB = X[4] * o.kk[0].xy;
    aA += X[1] * o.kk[0].zw; aB += X[5] * o.kk[0].zw;
    aA += X[2] * o.kk[1].xy; aB += X[6] * o.kk[1].xy;
    aA += X[3] * o.kk[1].zw; aB += X[7] * o.kk[1].zw;
    const float saA = sum8(aA.x + aA.y), saB = sum8(aB.x + aB.y);
    const f32x2 nA = (f32x2){-saA, -saA}, nB = (f32x2){-saB, -saB}, vA = (f32x2){o.v.x, o.v.x}, vB = (f32x2){o.v.y, o.v.y};
    f32x2 tA, tB, accA, accB;
    tA = X[0] * o.w[0].xy; tA += nA * b[0].xy; if (use_v) tA += vA * kd[0].xy; X[0] = tA; accA = tA * r[0].xy;
    tB = X[4] * o.w[0].xy; tB += nB * b[0].xy; if (use_v) tB += vB * kd[0].xy; X[4] = tB; accB = tB * r[0].xy;
    tA = X[1] * o.w[0].zw; tA += nA * b[0].zw; if (use_v) tA += vA * kd[0].zw; X[1] = tA; accA += tA * r[0].zw;
    tB = X[5] * o.w[0].zw; tB += nB * b[0].zw; if (use_v) tB += vB * kd[0].zw; X[5] = tB; accB += tB * r[0].zw;
    tA = X[2] * o.w[1].xy; tA += nA * b[1].xy; if (use_v) tA += vA * kd[1].xy; X[2] = tA; accA += tA * r[1].xy;
    tB = X[6] * o.w[1].xy; tB += nB * b[1].xy; if (use_v) tB += vB * kd[1].xy; X[6] = tB; accB += tB * r[1].xy;
    tA = X[3] * o.w[1].zw; tA += nA * b[1].zw; if (use_v) tA += vA * kd[1].zw; X[3] = tA; accA += tA * r[1].zw;
    tB = X[7] * o.w[1].zw; tB += nB * b[1].zw; if (use_v) tB += vB * kd[1].zw; X[7] = tB; accB += tB * r[1].zw;
    yA = sum8(accA.x + accA.y); yB = sum8(accB.x + accB.y);
}
__device__ __forceinline__ void scan_step1(f32x2 (&X)[8], const ScanOps& o, const float* oi, float& yA, float& yB) {
    f32x4 b[2], kd[2], r[2];
#pragma unroll
    for (int j4 = 0; j4 < 2; ++j4) { b[j4] = *(const f32x4*)(oi + 2048 + 4 * j4); kd[j4] = *(const f32x4*)(oi + 3072 + 4 * j4); r[j4] = *(const f32x4*)(oi + 4096 + 4 * j4); }
    scan_rows(X, o, b, kd, r, true, yA, yB);
}
__device__ __forceinline__ void scan_step2(f32x2 (&S2)[8], f32x2 (&P2)[8], const ScanOps& o, const float* oi, const bool hasP, float& ysA, float& ysB, float& yqA, float& yqB) {
    f32x4 b[2], kd[2], r[2];
#pragma unroll
    for (int j4 = 0; j4 < 2; ++j4) { b[j4] = *(const f32x4*)(oi + 2048 + 4 * j4); kd[j4] = *(const f32x4*)(oi + 3072 + 4 * j4); r[j4] = *(const f32x4*)(oi + 4096 + 4 * j4); }
    scan_rows(S2, o, b, kd, r, true, ysA, ysB);
    if (hasP) scan_rows(P2, o, b, kd, r, false, yqA, yqB);
}
__device__ void phase_scan(int c, const bf16_t* PROJ, const float* k_k, const bf16_t* Wd, const bf16_t* Bd, const float* k_a, bf16_t* Y, bf16_t* Q, float* FS, float* sm) {
    const int L = (c == 0) ? 8192 : 2048;
    const int nunit = 256;
    const int bid = o_bid(), nblk = o_nblk();
    const int tid = o_tid(), ub = tid >> 8, tu = tid & 255, wq = tu >> 6, lane = tu & 63, q = lane & 7, vp = lane >> 3;
    float* opb = sm;
    float* ybw = sm + 12288 + wq * 2064;
    float* qbw = sm + 12288 + 8256 + wq * 2064;
    const int ild = tu >> 4, k4 = (tu & 15) * 4;
    const int nch = 128;
    for (int u = bid; u < nunit; u += nblk) {
        const bool roleP = (ub == 1), ldr = (ub == 1);
        const int base = (c == 0) ? (u >> 2) : u, j = (c == 0) ? (u & 3) : 0; const bool hasP = j > 0; const int g0 = 2048 * j;
        const int dir = base & 1, h = (base >> 1) & 7, seq = base >> 4;
        const size_t hc = (size_t)h * 64 + k4;
        const bool act = !roleP || hasP;
        f32x2 X[8];
#pragma unroll
        for (int jj = 0; jj < 8; ++jj) { const int rw = 16 * wq + 2 * vp + (jj >> 2), kx = 8 * q + 2 * (jj & 3);
            X[jj].x = (roleP && kx == rw) ? 1.f : 0.f; X[jj].y = (roleP && kx + 1 == rw) ? 1.f : 0.f; }
        float* obw = roleP ? qbw : ybw; bf16_t* gout = roleP ? Q : Y;
        f32x4 pw = (f32x4){0.f, 0.f, 0.f, 0.f}; uint2 pkk = make_uint2(0, 0), pb = pkk, pkd = pkk, pr = pkk, pv = pkk;
        const f32x4 ka4 = *(const f32x4*)(k_a + hc), kk4 = *(const f32x4*)(k_k + hc);
        auto issue = [&](int ci) {
            const int g = g0 + ci * 16 + ild; const int t = dir ? (L - 1 - g) : g;
            const size_t row = (size_t)seq * L + t;
            { const uint2 wq2 = *(const uint2*)(Wd + ((size_t)dir * TCH + row) * 512 + hc); pw = (f32x4){bflo(wq2.x), bfhi(wq2.x), bflo(wq2.y), bfhi(wq2.y)}; }
            pb = *(const uint2*)(Bd + ((size_t)dir * TCH + row) * 512 + hc);
            pkd = *(const uint2*)(PROJ + row * LDP + C_K + hc);
            pr = *(const uint2*)(PROJ + row * LDP + C_R + hc);
            pv = *(const uint2*)(PROJ + row * LDP + C_V + hc);
        };
        auto stash = [&](int buf) {
            float* o = opb + buf * 6144 + ild * 64 + k4;
            const float ap[4] = {bflo(pb.x), bfhi(pb.x), bflo(pb.y), bfhi(pb.y)}, kv[4] = {bflo(pkd.x), bfhi(pkd.x), bflo(pkd.y), bfhi(pkd.y)};
            float kkv[4]; float ss = 0.f;
#pragma unroll
            for (int e = 0; e < 4; ++e) { kkv[e] = kv[e] * kk4[e]; ss += kkv[e] * kkv[e]; }
            ss = sum16(ss); const float rn = 1.0f / fmaxf(sqrtf(ss), 1e-12f);
#pragma unroll
            for (int e = 0; e < 4; ++e) kkv[e] *= rn;
            f32x4 wv, bv, kdv;
#pragma unroll
            for (int e = 0; e < 4; ++e) { const float zz = -pw[e]; const float sp = fmaxf(zz, 0.f) + __logf(1.0f + __expf(-fabsf(zz)));
                wv[e] = __expf(-__expf(-sp - 0.5f)); const float a = sigmoidf_(ap[e]); bv[e] = kkv[e] * a; kdv[e] = kv[e] * (1.0f + (a - 1.0f) * ka4[e]); }
            *(f32x4*)(o) = wv;
            *(f32x4*)(o + 1024) = (f32x4){kkv[0], kkv[1], kkv[2], kkv[3]};
            *(f32x4*)(o + 2048) = bv;
            *(f32x4*)(o + 3072) = kdv;
            *(f32x4*)(o + 4096) = (f32x4){bflo(pr.x), bfhi(pr.x), bflo(pr.y), bfhi(pr.y)};
            *(f32x4*)(o + 5120) = (f32x4){bflo(pv.x), bfhi(pv.x), bflo(pv.y), bfhi(pv.y)};
        };
        __syncthreads();
        if (ldr) { issue(0); stash(0); issue(1); }
        __syncthreads();
        for (int ci = 0; ci < nch; ++ci) {
            if (ldr && ci + 1 < nch) { stash((ci + 1) & 1); if (ci + 2 < nch) issue(ci + 2); }
            if (act) {
                const float* ob = opb + (ci & 1) * 6144 + q * 8;
                const float* obv = opb + (ci & 1) * 6144 + 5120 + wq * 16 + 2 * vp;
                ScanOps A, B;
                scan_ld(ob, obv, 0, A);
#pragma unroll
                for (int i = 0; i < 16; i += 2) {
                    float yA = 0.f, yB = 0.f;
                    scan_ld(ob, obv, i + 1, B);
                    if (roleP) A.v = (f32x2){0.f, 0.f};
                    scan_step1(X, A, ob + i * 64, yA, yB);
                    *(f32x2*)(obw + q * 258 + i * 16 + 2 * vp) = (f32x2){yA, yB};
                    if (i + 2 < 16) scan_ld(ob, obv, i + 2, A);
                    if (roleP) B.v = (f32x2){0.f, 0.f};
                    scan_step1(X, B, ob + (i + 1) * 64, yA, yB);
                    *(f32x2*)(obw + q * 258 + (i + 1) * 16 + 2 * vp) = (f32x2){yA, yB};
                }
                __builtin_amdgcn_wave_barrier(); asm volatile("s_waitcnt lgkmcnt(0)" ::: "memory");
                { const int st = lane >> 2, v4 = (lane & 3) * 4;
                  const int g = g0 + ci * 16 + st; const int t = dir ? (L - 1 - g) : g;
                  const size_t o = ((size_t)dir * TCH + (size_t)seq * L + t) * 512 + h * 64 + wq * 16 + v4;
                  const f32x4 yv = *(const f32x4*)(obw + st * 16 + v4);
                  uint2 pk; pk.x = pack2(yv[0], yv[1]); pk.y = pack2(yv[2], yv[3]); *(uint2*)(gout + o) = pk; }
                __builtin_amdgcn_wave_barrier();
            }
            __syncthreads();
        }
        if (act && c == 0) {
            float* fs = FS + ((size_t)(base * 7 + (roleP ? 3 + j : j)) * 64 + wq * 16 + 2 * vp) * 64 + q * 8;
            *(f32x4*)(fs) = (f32x4){X[0].x, X[0].y, X[1].x, X[1].y}; *(f32x4*)(fs + 4) = (f32x4){X[2].x, X[2].y, X[3].x, X[3].y};
            *(f32x4*)(fs + 64) = (f32x4){X[4].x, X[4].y, X[5].x, X[5].y}; *(f32x4*)(fs + 68) = (f32x4){X[6].x, X[6].y, X[7].x, X[7].y};
        }
    }
}

__device__ void phase_fixup(const float* FS, const bf16_t* Q, bf16_t* Y, float* sm) {
    const int L = 8192;
    const int tid = o_tid(), bid = o_bid(), nblk = o_nblk();
    float* A = sm; float* B = sm + 4160; float* qs = sm + 8320;
    for (int item = bid; item < 192; item += nblk) {
        const int base = item / 3, j = item % 3 + 1;
        const int dir = base & 1, h = (base >> 1) & 7, seq = base >> 4;
        const float* SL = FS + (size_t)(base * 7) * 4096; const float* PF = FS + (size_t)(base * 7 + 3) * 4096;
        __syncthreads();
        for (int idx = tid; idx < 4096; idx += 512) A[(idx >> 6) * 65 + (idx & 63)] = SL[idx];
        __syncthreads();
        float* cur = A; float* nxt = B;
        for (int jj = 1; jj < j; ++jj) {
            const int v = tid >> 3, kc = (tid & 7) * 8;
            const float* P = PF + (size_t)jj * 4096 + kc;
            f32x4 a0 = *(const f32x4*)(SL + (size_t)jj * 4096 + v * 64 + kc), a1 = *(const f32x4*)(SL + (size_t)jj * 4096 + v * 64 + kc + 4);
            for (int m = 0; m < 64; ++m) { const float cv = cur[v * 65 + m]; a0 += cv * *(const f32x4*)(P + m * 64); a1 += cv * *(const f32x4*)(P + m * 64 + 4); }
#pragma unroll
            for (int e = 0; e < 4; ++e) { nxt[v * 65 + kc + e] = a0[e]; nxt[v * 65 + kc + 4 + e] = a1[e]; }
            __syncthreads();
            float* tsw = cur; cur = nxt; nxt = tsw;
        }
        const int v = tid & 63, tg = tid >> 6;
        float s0[64];
#pragma unroll
        for (int m = 0; m < 64; ++m) s0[m] = cur[v * 65 + m];
        float* qw = qs + tg * 64;
        for (int sg = tg; sg < 2048; sg += 8) {
            const int g = 2048 * j + sg; const int t = dir ? (L - 1 - g) : g;
            const size_t o = ((size_t)dir * TCH + (size_t)seq * L + t) * 512 + h * 64 + v;
            qw[v] = bf2f(Q[o]);
            __builtin_amdgcn_wave_barrier(); asm volatile("s_waitcnt lgkmcnt(0)" ::: "memory");
            float acc = 0.f;
#pragma unroll
            for (int m4 = 0; m4 < 16; ++m4) { const f32x4 qq = *(const f32x4*)(qw + 4 * m4); acc += s0[4 * m4] * qq[0] + s0[4 * m4 + 1] * qq[1] + s0[4 * m4 + 2] * qq[2] + s0[4 * m4 + 3] * qq[3]; }
            __builtin_amdgcn_wave_barrier();
            Y[o] = f2bf(bf2f(Y[o]) + acc);
        }
    }
}

__device__ void phase_post(KP p, int l, const bf16_t* __restrict__ PROJ, const bf16_t* __restrict__ Y, const bf16_t* __restrict__ GG, bf16_t* __restrict__ OB) {
    const int tid = o_tid(), wave = tid >> 6, lane = tid & 63; const int bid = o_bid(), nblk = o_nblk();
    const int c8 = lane * 8;
    float rk[8], gnw[8], gnb[8];
#pragma unroll
    for (int e = 0; e < 8; ++e) { rk[e] = p->in[21][l * 512 + c8 + e]; gnw[e] = p->in[22][l * 512 + c8 + e]; gnb[e] = p->in[23][l * 512 + c8 + e]; }
#pragma unroll 2
    for (int r = bid * 8 + wave; r < TCH; r += nblk * 8) {
        const uint4 yfq = *(const uint4*)(Y + (size_t)r * 512 + c8), ybq = *(const uint4*)(Y + ((size_t)TCH + r) * 512 + c8);
        const bf16_t* pr = PROJ + (size_t)r * LDP;
        const uint4 rq = *(const uint4*)(pr + C_R + c8), kq = *(const uint4*)(pr + C_K + c8), vq = *(const uint4*)(pr + C_V + c8), gq = *(const uint4*)(GG + (size_t)r * 512 + c8);
        float y[8], rr[8], kk[8], vv[8], g[8], o[8];
#pragma unroll
        for (int e = 0; e < 4; ++e) { y[e] = 0.f; y[4 + e] = 0.f; }
        { float ya[8], yb8[8]; unpack8(yfq, ya); unpack8(ybq, yb8);
#pragma unroll
          for (int e = 0; e < 8; ++e) y[e] = ya[e] + yb8[e]; }
        float s = 0.f;
#pragma unroll
        for (int e = 0; e < 8; ++e) s += y[e];
        const float mean = sum8(s) * (1.0f / 64.0f);
        float s2 = 0.f;
#pragma unroll
        for (int e = 0; e < 8; ++e) { y[e] -= mean; s2 += y[e] * y[e]; }
        const float rstd = rsqrtf(sum8(s2) * (1.0f / 64.0f) + 64e-5f);
        unpack8(rq, rr); unpack8(kq, kk); unpack8(vq, vv); unpack8(gq, g);
        float bs = 0.f;
#pragma unroll
        for (int e = 0; e < 8; ++e) bs += rr[e] * kk[e] * rk[e];
        bs = sum8(bs);
#pragma unroll
        for (int e = 0; e < 8; ++e) o[e] = (y[e] * rstd * gnw[e] + gnb[e] + bs * vv[e]) * g[e];
        *(uint4*)(OB + (size_t)r * 1024 + 512 + c8) = pack8(o);
    }
}

constexpr int NPH0 = 15 + 14, NPHX = 14 + 13;
__device__ __forceinline__ int sub_of(int idx) { return idx + (idx >= 7) + (idx >= 10) + (idx >= 12); }
__device__ __forceinline__ void run_phase(KP p, int ph, unsigned char* shm) {
    float* smf = (float*)shm;
    if (ph == 0) { phase_weights(p, smf); return; }
    int q = ph - 1, c, l, s;
    if (q < NPH0) { c = 0; l = q >= 15; int idx = l ? q - 15 + 1 : q; s = (idx <= 4) ? idx : (idx == 5 ? 17 : sub_of(idx - 1)); }
    else { q -= NPH0; c = 1 + q / NPHX; q %= NPHX; l = q >= 14; s = sub_of(l ? q - 14 + 1 : q); }
    const int L = (c == 0) ? 8192 : 2048;
    unsigned char* ws = p->ws;
    using namespace pg8;
    const bool is_gemm = (s == 1) | (s == 3) | (s == 6) | (s == 8) | (s == 10) | (s == 12) | (s == 15);
    if (is_gemm) {
        const bf16_t* wl = (const bf16_t*)(ws + OFF_W) + (size_t)l * W_LAYER;
        bf16_t* RU = (bf16_t*)(ws + OFF_U);
        const int ng = (s == 12) ? 2 : 1;
        for (int gi = 0; gi < ng; ++gi) {
            const int se = (gi == 0) ? s : 14;
            Gemm g;
            switch (se) {
            case 1: g = Gemm{RU, wl + W_IN, DM, DM, TCH / 256, LDP, DM, 0, 1}; break;
            case 3: g = Gemm{(bf16_t*)(ws + OFF_ZT), (const bf16_t*)(ws + OFF_LORA) + (size_t)l * LORA_ELEMS, LORA_K, LORA_K, TCH / 256, LORA_N, LORA_K, 0, 1}; break;
            case 6: g = Gemm{(bf16_t*)(ws + OFF_M), wl + W_A, DM, DM, TCH / 256, DM, 512, 2, 1}; break;
            case 8: g = Gemm{RU, wl + W_OUT, DM, DM, TCH / 256, DM, DM, 0, 1}; break;
            case 10: g = Gemm{RU - DM, wl + W_UP, DM, DM, (TCH + 247) / 248, LDP, DM, 1, 0}; break;
            case 12: g = Gemm{(bf16_t*)(ws + OFF_S), wl + W_DOWN, DFF, DFF, TCH / 256, DM, DFF, 0, 1}; break;
            case 14: g = Gemm{(bf16_t*)(ws + OFF_S + 176 * MiB), wl + W_PLE, DPLE, DPLE, TCH / 256, DM, DPLE, 0, 1}; break;
            default: g = Gemm{(bf16_t*)(ws + OFF_XB), wl + W_PG, DM, DM, TCH / 256, DM, DM, 0, 1}; break;
            }
            const EpiAny e{p, se, l, L};
            gemm_phase((LAS unsigned char*)shm, g, e);
        }
        return;
    }
    if (s == 2) { phase_prep_ew(p, l, L, (const bf16_t*)(ws + OFF_P), (bf16_t*)(ws + OFF_M), (bf16_t*)(ws + OFF_M + 64 * MiB), (bf16_t*)(ws + OFF_ZT)); return; }
    if (s == 4) { phase_scan(c, (const bf16_t*)(ws + OFF_P), p->in[19] + (size_t)l * 512, (const bf16_t*)(ws + OFF_S), (const bf16_t*)(ws + OFF_S + 128 * MiB),
                             p->in[20] + (size_t)l * 512, (bf16_t*)(ws + OFF_Y), (bf16_t*)(ws + OFF_S + 192 * MiB), (float*)(ws + OFF_FS), smf); return; }
    if (s == 17) { phase_fixup((const float*)(ws + OFF_FS), (const bf16_t*)(ws + OFF_S + 192 * MiB), (bf16_t*)(ws + OFF_Y), smf); return; }
    if (s == 5) { phase_post(p, l, (const bf16_t*)(ws + OFF_P), (const bf16_t*)(ws + OFF_Y), (const bf16_t*)(ws + OFF_GG), (bf16_t*)(ws + OFF_M)); return; }
    {
        float* xout = p->out + (size_t)c * TCH * DM;
        const float* x0 = (c == 0) ? p->in[0] : p->in[1] + (size_t)(c - 1) * TCH * DM;
        bf16_t* RU = (bf16_t*)(ws + OFF_U); bf16_t* XB = (bf16_t*)(ws + OFF_XB); const bf16_t* MF = (const bf16_t*)(ws + OFF_M);
        const int xsrc = (l == 0) ? 0 : 16;
        if (s == 0) phase_rows(2, x0, XB, nullptr, nullptr, p->in[4] + l * DM, nullptr, RU, nullptr, nullptr);
        else if (s == 9) { const float* pin = (c == 0) ? p->in[2] + (size_t)l * 32768 * DPLE : p->in[3] + (size_t)l * 65536 * DPLE + (size_t)(c - 1) * TCH * DPLE;
            phase_rows(1 | 2 | 8 | xsrc, x0, XB, MF, p->in[5] + l * DM, p->in[6] + l * DM, nullptr, RU, pin, (bf16_t*)(ws + OFF_S + 176 * MiB)); }
        else if (s == 13) phase_rows(1 | 16, nullptr, XB, MF, p->in[7] + l * DM, nullptr, nullptr, nullptr, nullptr, nullptr);
        else if (l == 0) phase_rows(1 | 2 | 16, nullptr, XB, MF, p->in[8] + l * DM, p->in[4] + (l + 1) * DM, nullptr, RU, nullptr, nullptr);
        else phase_rows(1 | 16 | 32, nullptr, XB, MF, p->in[8] + l * DM, nullptr, xout, nullptr, nullptr, nullptr);
    }
}

__device__ __forceinline__ void fast_barrier(unsigned* bar, unsigned target) {
    asm volatile("s_waitcnt vmcnt(0)" ::: "memory");
    __syncthreads();
    if (threadIdx.x == 0) {
        __builtin_amdgcn_fence(__ATOMIC_RELEASE, "agent");
        asm volatile("s_waitcnt vmcnt(0)" ::: "memory");
        (void)__hip_atomic_fetch_add(bar, 1u, __ATOMIC_RELAXED, __HIP_MEMORY_SCOPE_AGENT);
        unsigned spins = 0;
        while (__hip_atomic_load(bar, __ATOMIC_RELAXED, __HIP_MEMORY_SCOPE_AGENT) < target) { __builtin_amdgcn_s_sleep(1); if (++spins > (1u << 24)) break; }
        __builtin_amdgcn_fence(__ATOMIC_ACQUIRE, "agent");
        asm volatile("s_waitcnt vmcnt(0)" ::: "memory");
    }
    __syncthreads();
}

__global__ void __launch_bounds__(512, 2) fwd_megakernel(Params p, int ph_lo, int ph_hi) {
    extern __shared__ __attribute__((aligned(16))) unsigned char shm[];
    cg::grid_group grid = cg::this_grid();
    unsigned nbar = 0;
    for (int ph = ph_lo; ph < ph_hi; ++ph) {
        KP kp = (KP)__builtin_amdgcn_kernarg_segment_ptr();
        asm volatile("" : "+s"(kp));
        run_phase(kp, ph, shm);
        if (ph + 1 < ph_hi) {
            if (ph == ph_lo) grid.sync();
            else { ++nbar; fast_barrier((unsigned*)(kp->ws + OFF_BAR), nbar * gridDim.x); }
        }
    }
}

extern "C" void kernel_launch(void* const* d_in, const int* in_sizes, int n_in, void* d_out, int out_size, void* d_ws, size_t ws_size, hipStream_t stream) {
    static int grid_blocks = 0;
    if (!grid_blocks) {
        (void)hipFuncSetAttribute((const void*)fwd_megakernel, hipFuncAttributeMaxDynamicSharedMemorySize, SMEM_BYTES);
        int dev = 0, cus = 0, per_cu = 0;
        (void)hipGetDevice(&dev);
        (void)hipDeviceGetAttribute(&cus, hipDeviceAttributeMultiprocessorCount, dev);
        (void)hipOccupancyMaxActiveBlocksPerMultiprocessor(&per_cu, fwd_megakernel, 512, SMEM_BYTES);
        if (per_cu < 1) per_cu = 1;
        if (per_cu > 1) per_cu = 1;
        grid_blocks = cus * per_cu;
    }
    Params p{};
    for (int i = 0; i < 32; ++i) p.in[i] = (const float*)d_in[i];
    p.out = (float*)d_out; p.ws = (unsigned char*)d_ws;
#if ONE_LAUNCH
    (void)hipMemsetAsync((unsigned char*)d_ws + OFF_BAR, 0, 256, stream);
    int lo = 0, hi = NPH;
    void* args[] = {&p, &lo, &hi};
    hipError_t e = hipLaunchCooperativeKernel((void*)fwd_megakernel, dim3(grid_blocks), dim3(512), args, SMEM_BYTES, stream);
    if (e != hipSuccess) fprintf(stderr, "cooperative launch failed: %s (grid %d)\n", hipGetErrorString(e), grid_blocks);
#else
    for (int ph = 0; ph < NPH; ++ph) fwd_megakernel<<<grid_blocks, 512, SMEM_BYTES, stream>>>(p, ph, ph + 1);
#endif
}
```

```cpp
#include <hip/hip_runtime.h>
#include <hip/hip_cooperative_groups.h>
#include <cstdio>
namespace cg = cooperative_groups;

#define LAS __attribute__((address_space(3)))
typedef unsigned short bf16_t;
typedef short bf16x8 __attribute__((ext_vector_type(8)));
typedef float f32x4 __attribute__((ext_vector_type(4)));

#ifndef ONE_LAUNCH
#define ONE_LAUNCH 1
#endif

constexpr int DM = 1024, TCH = 32768  , NCHUNK = 3, NLAYER = 2;
constexpr int INC = 5504, LDP = 5632  , DFF = 2816, DPLE = 256;
constexpr int C_HC = 0, C_BG = 512, C_CG = 1024, C_R = 1536, C_K = 2048, C_V = 2560, C_ZF = 3072, C_ZB = 3200, C_GD = 3328, C_GC = 3456, C_GR = 4480;
constexpr size_t W_IN = 0, W_A = 5767168, W_B = 6291456, W_OUT = 6815744, W_UP = 7864320, W_DOWN = 13631488, W_PLE = 16515072, W_PG = 16777216, W_LAYER = 17825792;
constexpr size_t MiB = 1048576;
constexpr size_t OFF_W = 0, OFF_U = 68 * MiB, OFF_P = 132 * MiB, OFF_M = 484 * MiB, OFF_S = 612 * MiB, OFF_LORA = 996 * MiB;
constexpr int LORA_N = 2560, LORA_K = 384; constexpr size_t LORA_ELEMS = (size_t)LORA_N * LORA_K;
constexpr size_t OFF_FS = 1000 * MiB;
constexpr size_t OFF_Y = OFF_S + 256 * MiB, OFF_XB = OFF_S + 320 * MiB;
constexpr size_t OFF_BAR = 1008 * MiB;
constexpr size_t OFF_GG = OFF_U, OFF_ZT = OFF_M + 96 * MiB;
constexpr int NPH = 1 + 29 + 2 * 27;
constexpr int SMEM_BYTES = 131072;

struct Params { const float* in[32]; float* out; unsigned char* ws; };
typedef const __attribute__((address_space(4))) Params* KP;

__device__ __forceinline__ bf16_t f2bf(float f) { unsigned u = __float_as_uint(f); u += 0x7FFFu + ((u >> 16) & 1u); return (bf16_t)(u >> 16); }
__device__ __forceinline__ float bf2f(unsigned b) { return __uint_as_float(b << 16); }
__device__ __forceinline__ unsigned pack2(float lo, float hi) { return (unsigned)f2bf(lo) | ((unsigned)f2bf(hi) << 16); }
__device__ __forceinline__ float bflo(unsigned u) { return __uint_as_float(u << 16); }
__device__ __forceinline__ float bfhi(unsigned u) { return __uint_as_float(u & 0xffff0000u); }
__device__ __forceinline__ float wave_sum(float v) {
#pragma unroll
    for (int o = 32; o > 0; o >>= 1) v += __shfl_xor(v, o, 64);
    return v;
}
__device__ __forceinline__ int o_tid() { int t = threadIdx.x; asm volatile("" : "+v"(t)); return t; }
__device__ __forceinline__ int o_bid() { int t = blockIdx.x; asm volatile("" : "+s"(t)); return t; }
__device__ __forceinline__ int o_nblk() { int t = gridDim.x; asm volatile("" : "+s"(t)); return t; }
__device__ __forceinline__ float sigmoidf_(float x) { return __builtin_amdgcn_rcpf(1.0f + __expf(-x)); }

__device__ __forceinline__ float dpp_xor1(float x) { return __int_as_float(__builtin_amdgcn_update_dpp(0, __float_as_int(x), 0xB1, 0xF, 0xF, true)); }
__device__ __forceinline__ float dpp_xor2(float x) { return __int_as_float(__builtin_amdgcn_update_dpp(0, __float_as_int(x), 0x4E, 0xF, 0xF, true)); }
__device__ __forceinline__ float dpp_hmirror(float x) { return __int_as_float(__builtin_amdgcn_update_dpp(0, __float_as_int(x), 0x141, 0xF, 0xF, true)); }
__device__ __forceinline__ float dpp_rmirror(float x) { return __int_as_float(__builtin_amdgcn_update_dpp(0, __float_as_int(x), 0x140, 0xF, 0xF, true)); }
__device__ __forceinline__ float sum16(float x) { x += dpp_xor1(x); x += dpp_xor2(x); x += dpp_hmirror(x); x += dpp_rmirror(x); return x; }
__device__ __forceinline__ float sum8(float x) { x += dpp_xor1(x); x += dpp_xor2(x); x += dpp_hmirror(x); return x; }
__device__ __forceinline__ void unpack8(const uint4 u, float (&f)[8]) { f[0] = bflo(u.x); f[1] = bfhi(u.x); f[2] = bflo(u.y); f[3] = bfhi(u.y); f[4] = bflo(u.z); f[5] = bfhi(u.z); f[6] = bflo(u.w); f[7] = bfhi(u.w); }
__device__ __forceinline__ uint4 pack8(const float (&f)[8]) { uint4 u; u.x = pack2(f[0], f[1]); u.y = pack2(f[2], f[3]); u.z = pack2(f[4], f[5]); u.w = pack2(f[6], f[7]); return u; }

namespace pg8 {
constexpr int BM = 256, BK = 64, HALF = 128, HTB = HALF * BK * 2, NXCD = 8, WGM = 8;
__device__ __forceinline__ int lds_byte(int r, int c) { const int st = (r >> 4) * 2 + (c >> 5), rr = r & 15, cc = c & 31, ob = rr * 64 + cc * 2; return st * 1024 + (ob ^ (((ob >> 9) & 1) << 5)); }
__device__ __forceinline__ void stage_rc(int b, int& R, int& C) { const int st = b / 1024, sb = b % 1024, swz = sb ^ (((sb >> 9) & 1) << 5); R = (st >> 1) * 16 + swz / 64; C = (st & 1) * 32 + (swz % 64) / 2; }
struct Unit { int pm, pn; };
struct Gemm { const bf16_t* A; const bf16_t* Bt; int lda, ldb, nM, N, K, ovl, perm; };
struct StaticOrder {
    int nM, nN, nwg, G, c;
    __device__ void init(int nM_, int N, int G_, int c_) { nM = nM_; nN = N / BM; nwg = nM * nN; G = G_; c = c_; }
    __device__ bool next(int i, Unit& u) const {
        const long L = (long)i * G + c; if (L >= nwg) return false;
        int wgid = (int)L; { const int q = nwg / NXCD, r = nwg % NXCD, xcd = wgid % NXCD, off = wgid / NXCD; wgid = (xcd < r ? xcd * (q + 1) : r * (q + 1) + (xcd - r) * q) + off; }
        const int nig = WGM * nN, gid = wgid / nig, fm = gid * WGM, gsz = (nM - fm) < WGM ? (nM - fm) : WGM;
        u.pm = fm + ((wgid % nig) % gsz); u.pn = (wgid % nig) / gsz; return true;
    }
};

template <class Epi>
__device__ __forceinline__ void gemm_phase(LAS unsigned char* lds, const Gemm g, const Epi& E) {
    const int tid = o_tid(), wid = __builtin_amdgcn_readfirstlane(tid >> 6), lane = tid & 63, wr = wid >> 2, wc = wid & 3, fr = lane & 15, fq = lane >> 4;
    const int K = g.K, nt = K / BK;
    StaticOrder S; S.init(g.nM, g.N, o_nblk(), o_bid());
    unsigned voffA[2], voffB[2];
#pragma unroll
    for (int i = 0; i < 2; ++i) { int R, C; stage_rc(tid * 16 + i * 8192, R, C); const int Ra = (g.ovl == 1) ? (R >> 6) * 62 + (R & 63) : R;
        const int Rb = g.perm ? ((R & ~31) + 8 * ((R & 15) >> 2) + 4 * ((R >> 4) & 1) + (R & 3)) : R;
        voffA[i] = (unsigned)(Ra * g.lda + C) * 2u; voffB[i] = (unsigned)(Rb * g.ldb + C) * 2u; }
    const size_t kstep = (size_t)(BK * 2);
    const size_t hstepA = (size_t)((g.ovl == 1) ? 124 : HALF) * g.lda * 2, hstepB = (size_t)HALF * g.ldb * 2;
    const size_t tstepA = 2 * hstepA, tstepB = 2 * hstepB;
    const unsigned ldsw = (unsigned)wid * 1024u;
    const int aoff = lds_byte(wr * 64 + fr, fq * 8), boff = lds_byte(wc * 32 + fr, fq * 8);
#define PG8_SA(b, h) (((b) * 2 + (h)) * HTB)
#define PG8_SB(b, h) ((4 + (b) * 2 + (h)) * HTB)
#define PG8_STAGE(bufoff, gbase, voff) do { _Pragma("unroll") for (int _i = 0; _i < 2; ++_i) \
        __builtin_amdgcn_global_load_lds((const unsigned*)((const char*)(gbase) + (voff)[_i]), (LAS unsigned*)(lds + (bufoff) + ldsw + _i * 8192), 16, 0, 0); } while (0)
#define PG8_LDA(dst, b, h) do { _Pragma("unroll") for (int m = 0; m < 4; ++m) _Pragma("unroll") for (int k = 0; k < 2; ++k) dst[m][k] = *(const LAS bf16x8*)(lds + PG8_SA(b, h) + aoff + m * 2048 + k * 1024); } while (0)
#define PG8_LDB(dst, b, h) do { _Pragma("unroll") for (int n = 0; n < 2; ++n) _Pragma("unroll") for (int k = 0; k < 2; ++k) dst[n][k] = *(const LAS bf16x8*)(lds + PG8_SB(b, h) + boff + n * 2048 + k * 1024); } while (0)
#define PG8_MMA(ai, bj, At, Bt) do { __builtin_amdgcn_s_setprio(1); _Pragma("unroll") for (int m = 0; m < 4; ++m) _Pragma("unroll") for (int n = 0; n < 2; ++n) _Pragma("unroll") for (int k = 0; k < 2; ++k) \
        acc[ai][bj][m][n] = __builtin_amdgcn_mfma_f32_16x16x32_bf16(Bt[n][k], At[m][k], acc[ai][bj][m][n], 0, 0, 0); __builtin_amdgcn_s_setprio(0); } while (0)
#define PG8_WAIT_V(n) asm volatile("s_waitcnt vmcnt(" #n ")" ::: "memory")
#define PG8_WAIT_L(n) asm volatile("s_waitcnt lgkmcnt(" #n ")" ::: "memory")
#define PG8_BAR __builtin_amdgcn_s_barrier()
#define PG8_SCHED __builtin_amdgcn_sched_barrier(0)
    const bool split = (g.ovl == 2); const size_t koff = (size_t)g.K * 2;
    Unit cur, nxt; int ui = 0, chalf = 0, nhalf = 0;
    if (!S.next(0, cur)) return;
    f32x4 acc[2][2][4][2];
#pragma unroll
    for (int a = 0; a < 2; ++a)
#pragma unroll
        for (int b = 0; b < 2; ++b)
#pragma unroll
            for (int m = 0; m < 4; ++m)
#pragma unroll
                for (int n = 0; n < 2; ++n) acc[a][b][m][n] = (f32x4){0.f, 0.f, 0.f, 0.f};
    bf16x8 At[4][2], B0[2][2], B1[2][2];
    const char* cA = (const char*)g.A + (size_t)cur.pm * tstepA; const char* cB = (const char*)g.Bt + (size_t)cur.pn * tstepB;
    PG8_STAGE(PG8_SB(0, 0), cB, voffB); PG8_STAGE(PG8_SA(0, 0), cA, voffA); PG8_STAGE(PG8_SB(0, 1), cB + hstepB, voffB); PG8_STAGE(PG8_SA(0, 1), cA + hstepA, voffA);
    if (wr == 1) PG8_BAR;
    PG8_WAIT_V(4); PG8_BAR;
    PG8_STAGE(PG8_SB(1, 0), cB + kstep, voffB); PG8_STAGE(PG8_SA(1, 0), cA + kstep, voffA); PG8_STAGE(PG8_SB(1, 1), cB + hstepB + kstep, voffB);
    PG8_WAIT_V(6); PG8_BAR;
    for (;;) {
        nhalf = split ? ((ui + 1) & 1) : 0;
        const bool has_next = S.next(split ? ((ui + 1) >> 1) : (ui + 1), nxt);
        const char* nA = has_next ? (const char*)g.A + (size_t)nxt.pm * tstepA + (nhalf ? koff : 0) : cA; const char* nB = has_next ? (const char*)g.Bt + (size_t)nxt.pn * tstepB + (nhalf ? koff : 0) : cB;
        for (int t = 0; t < nt; t += 2) {
            const bool last = (t == nt - 2);
            const char* a1 = cA + (size_t)(t + 1) * kstep;
            const char* a2 = last ? nA : cA + (size_t)(t + 2) * kstep; const char* b2 = last ? nB : cB + (size_t)(t + 2) * kstep;
            const char* a3 = a2 + kstep; const char* b3 = b2 + kstep;
            PG8_LDB(B0, 0, 0); PG8_SCHED; PG8_LDA(At, 0, 0); PG8_STAGE(PG8_SA(1, 1), a1 + hstepA, voffA);
            PG8_WAIT_L(8); PG8_BAR; PG8_WAIT_L(0); PG8_MMA(0, 0, At, B0); PG8_BAR; PG8_SCHED;
            PG8_LDB(B1, 0, 1); PG8_STAGE(PG8_SB(0, 0), b2, voffB);
            PG8_BAR; PG8_WAIT_L(0); PG8_MMA(0, 1, At, B1); PG8_BAR;
            PG8_LDA(At, 0, 1); PG8_STAGE(PG8_SA(0, 0), a2, voffA);
            PG8_BAR; PG8_WAIT_L(0); PG8_MMA(1, 0, At, B0); PG8_BAR; PG8_SCHED;
            PG8_STAGE(PG8_SB(0, 1), b2 + hstepB, voffB);
            PG8_WAIT_V(6); PG8_BAR; PG8_MMA(1, 1, At, B1); PG8_BAR;
            PG8_LDB(B0, 1, 0); PG8_SCHED; PG8_LDA(At, 1, 0); PG8_STAGE(PG8_SA(0, 1), a2 + hstepA, voffA);
            PG8_WAIT_L(8); PG8_BAR; PG8_WAIT_L(0); PG8_MMA(0, 0, At, B0); PG8_BAR; PG8_SCHED;
            PG8_LDB(B1, 1, 1); PG8_STAGE(PG8_SB(1, 0), b3, voffB);
            PG8_BAR; PG8_WAIT_L(0); PG8_MMA(0, 1, At, B1); PG8_BAR;
            PG8_LDA(At, 1, 1); PG8_STAGE(PG8_SA(1, 0), a3, voffA);
            PG8_BAR; PG8_WAIT_L(0); PG8_MMA(1, 0, At, B0); PG8_BAR; PG8_SCHED;
            PG8_STAGE(PG8_SB(1, 1), b3 + hstepB, voffB);
            PG8_WAIT_V(6); PG8_BAR; PG8_MMA(1, 1, At, B1); PG8_BAR;
        }
        const bool is_mid = split && (chalf == 0);
        if (is_mid) E.mid(acc, cur, wr, wc, fr, fq); else E(acc, cur, wr, wc, fr, fq);
        if (!has_next) break;
        if (!is_mid)
#pragma unroll
        for (int a = 0; a < 2; ++a)
#pragma unroll
            for (int b = 0; b < 2; ++b)
#pragma unroll
                for (int m = 0; m < 4; ++m)
#pragma unroll
                    for (int n = 0; n < 2; ++n) acc[a][b][m][n] = (f32x4){0.f, 0.f, 0.f, 0.f};
        cur = nxt; cA = nA; cB = nB; ++ui; chalf = nhalf;
    }
    PG8_WAIT_V(0);
    if (wr == 0) PG8_BAR;
    PG8_BAR;
#undef PG8_SA
#undef PG8_SB
#undef PG8_STAGE
#undef PG8_LDA
#undef PG8_LDB
#undef PG8_MMA
#undef PG8_WAIT_V
#undef PG8_WAIT_L
#undef PG8_BAR
#undef PG8_SCHED
}

#define EPI_ROWS(...) \
    const int row0 = u.pm * BM + wr * 64 + fr, col0 = u.pn * BM + wc * 32 + 4 * fq; \
    _Pragma("unroll") for (int ai = 0; ai < 2; ++ai) _Pragma("unroll") for (int m = 0; m < 4; ++m) { const size_t row = (size_t)(row0 + ai * HALF + m * 16); __VA_ARGS__ }
#define EPI_COLS(...) \
    _Pragma("unroll") for (int bj = 0; bj < 2; ++bj) _Pragma("unroll") for (int n = 0; n < 2; ++n) { const int co = bj * HALF + n * 16; const f32x4 v = acc[ai][bj][m][n]; __VA_ARGS__ }

struct EpiBf16 {
    bf16_t* O; int ldc;
    __device__ __forceinline__ void operator()(const f32x4 (&acc)[2][2][4][2], const Unit& u, int wr, int wc, int fr, int fq) const {
        EPI_ROWS( bf16_t* rowp = O + row * ldc + col0;
            EPI_COLS( uint2 o; o.x = pack2(v[0], v[1]); o.y = pack2(v[2], v[3]); *(uint2*)(rowp + co) = o; ) )
    }
};
struct EpiF32 {
    float* C; int ldc;
    __device__ __forceinline__ void operator()(const f32x4 (&acc)[2][2][4][2], const Unit& u, int wr, int wc, int fr, int fq) const {
        EPI_ROWS( float* rowp = C + row * ldc + col0;
            EPI_COLS( *(f32x4*)(rowp + co) = v; ) )
    }
};
struct EpiGate2 {
    bf16_t* O; const bf16_t* gate;
    __device__ __forceinline__ void mid(f32x4 (&acc)[2][2][4][2], const Unit& u, int wr, int wc, int fr, int fq) const {
        EPI_ROWS( const bf16_t* gp = gate + row * LDP + col0;
            _Pragma("unroll") for (int bj = 0; bj < 2; ++bj) _Pragma("unroll") for (int n = 0; n < 2; ++n) { const int co = bj * HALF + n * 16;
                const uint2 gcq = *(const uint2*)(gp + C_GC + co), grq = *(const uint2*)(gp + C_GR + co);
                const float gc[4] = {bflo(gcq.x), bfhi(gcq.x), bflo(gcq.y), bfhi(gcq.y)}, gr[4] = {bflo(grq.x), bfhi(grq.x), bflo(grq.y), bfhi(grq.y)};
                _Pragma("unroll") for (int e = 0; e < 4; ++e) acc[ai][bj][m][n][e] *= sigmoidf_(gc[e]) * (1.0f + __expf(-fminf(fmaxf(gr[e], -30.f), 30.f))); } )
    }
    __device__ __forceinline__ void operator()(const f32x4 (&acc)[2][2][4][2], const Unit& u, int wr, int wc, int fr, int fq) const {
        EPI_ROWS( bf16_t* rowp = O + row * DM + col0; const bf16_t* gp = gate + row * LDP + C_GR + col0;
            EPI_COLS( const uint2 grq = *(const uint2*)(gp + co);
                const float r0 = sigmoidf_(fminf(fmaxf(bflo(grq.x), -30.f), 30.f)) * v[0], r1 = sigmoidf_(fminf(fmaxf(bfhi(grq.x), -30.f), 30.f)) * v[1];
                const float r2 = sigmoidf_(fminf(fmaxf(bflo(grq.y), -30.f), 30.f)) * v[2], r3 = sigmoidf_(fminf(fmaxf(bfhi(grq.y), -30.f), 30.f)) * v[3];
                uint2 o; o.x = pack2(r0, r1); o.y = pack2(r2, r3); *(uint2*)(rowp + co) = o; ) )
    }
};
struct EpiSigMul {
    bf16_t* O; const bf16_t* pp;
    __device__ __forceinline__ void operator()(const f32x4 (&acc)[2][2][4][2], const Unit& u, int wr, int wc, int fr, int fq) const {
        EPI_ROWS( bf16_t* rowp = O + row * DM + col0; const bf16_t* qp = pp + row * DM + col0;
            EPI_COLS( const uint2 pq = *(const uint2*)(qp + co);
                uint2 o; o.x = pack2(sigmoidf_(v[0]) * bflo(pq.x), sigmoidf_(v[1]) * bfhi(pq.x)); o.y = pack2(sigmoidf_(v[2]) * bflo(pq.y), sigmoidf_(v[3]) * bfhi(pq.y));
                *(uint2*)(rowp + co) = o; ) )
    }
};
__device__ __forceinline__ float dppf(float old, float src, const int ctrl_sel) {
    const int o = __float_as_int(old), x = __float_as_int(src); int r;
    if (ctrl_sel == 0) r = __builtin_amdgcn_update_dpp(o, x, 0x111, 0xF, 0xF, false);
    else if (ctrl_sel == 1) r = __builtin_amdgcn_update_dpp(o, x, 0x101, 0xF, 0xF, false);
    else if (ctrl_sel == 2) r = __builtin_amdgcn_update_dpp(o, x, 0x121, 0xF, 0xF, false);
    else r = __builtin_amdgcn_update_dpp(o, x, 0x12F, 0xF, 0xF, false);
    return __int_as_float(r);
}
struct EpiFfn {
    KP kp; int l, L;
    __device__ __forceinline__ void operator()(const f32x4 (&acc)[2][2][4][2], const Unit& u, int wr, int wc, int fr, int fq) const {
        unsigned char* ws = kp->ws;
        const float* cw = kp->in[27] + (size_t)l * 3 * 5632; const float* cb = kp->in[28] + (size_t)l * 5632;
#pragma unroll
        for (int bj = 0; bj < 2; ++bj) { const int J = u.pn * 128 + bj * 64 + wc * 16 + 4 * fq;
            const f32x4 wg0 = *(const f32x4*)(cw + J), wg1 = *(const f32x4*)(cw + 5632 + J), wg2 = *(const f32x4*)(cw + 11264 + J), bgv = *(const f32x4*)(cb + J);
            const f32x4 wv0 = *(const f32x4*)(cw + DFF + J), wv1 = *(const f32x4*)(cw + 5632 + DFF + J), wv2 = *(const f32x4*)(cw + 11264 + DFF + J), bvv = *(const f32x4*)(cb + DFF + J);
#pragma unroll
            for (int ai = 0; ai < 2; ++ai) { const int tb = u.pm * 248 + 62 * (ai * 2 + wr) - 1;
#pragma unroll
                for (int m = 0; m < 4; ++m) { const int r = 16 * m + fr, t = tb + r, pos = t & (L - 1);
                    const bool hp = pos != 0, hn = pos != L - 1, valid = (r >= 1) & (r <= 62) & (t < TCH);
                    float out[4];
#pragma unroll
                    for (int e = 0; e < 4; ++e) {
                        const float xg = acc[ai][bj][m][0][e], xv = acc[ai][bj][m][1][e];
                        float pg = dppf(m > 0 ? dppf(0.f, acc[ai][bj][m > 0 ? m - 1 : 0][0][e], 2) : 0.f, xg, 0);
                        float ng = dppf(m < 3 ? dppf(0.f, acc[ai][bj][m < 3 ? m + 1 : 3][0][e], 3) : 0.f, xg, 1);
                        float pv = dppf(m > 0 ? dppf(0.f, acc[ai][bj][m > 0 ? m - 1 : 0][1][e], 2) : 0.f, xv, 0);
                        float nv = dppf(m < 3 ? dppf(0.f, acc[ai][bj][m < 3 ? m + 1 : 3][1][e], 3) : 0.f, xv, 1);
                        if (!hp) { pg = 0.f; pv = 0.f; }
                        if (!hn) { ng = 0.f; nv = 0.f; }
                        const float hg = wg0[e] * pg + wg1[e] * xg + wg2[e] * ng + bgv[e], hv = wv0[e] * pv + wv1[e] * xv + wv2[e] * nv + bvv[e];
                        out[e] = hg * sigmoidf_(1.5957691216f * (hg + 0.044715f * hg * hg * hg)) * hv; }
                    if (valid) { uint2 o; o.x = pack2(out[0], out[1]); o.y = pack2(out[2], out[3]); *(uint2*)(ws + (unsigned)OFF_S + ((unsigned)t * (unsigned)DFF + (unsigned)J) * 2u) = o; }
                    __builtin_amdgcn_sched_barrier(0); } } }
    }
};
#define EPIP_ROWS(...) \
    const int row0 = u.pm * BM + wr * 64 + fr, col8 = u.pn * BM + wc * 32 + 8 * fq; \
    _Pragma("unroll") for (int ai = 0; ai < 2; ++ai) _Pragma("unroll") for (int m = 0; m < 4; ++m) { const size_t row = (size_t)(row0 + ai * HALF + m * 16); \
    _Pragma("unroll") for (int bj = 0; bj < 2; ++bj) { const int co = bj * HALF; const f32x4 v0 = acc[ai][bj][m][0], v1 = acc[ai][bj][m][1]; __VA_ARGS__ } }
struct EpiBf16P {
    bf16_t* O; int ldc;
    __device__ __forceinline__ void operator()(const f32x4 (&acc)[2][2][4][2], const Unit& u, int wr, int wc, int fr, int fq) const {
        EPIP_ROWS( uint4 o; o.x = pack2(v0[0], v0[1]); o.y = pack2(v0[2], v0[3]); o.z = pack2(v1[0], v1[1]); o.w = pack2(v1[2], v1[3]); *(uint4*)(O + row * ldc + col8 + co) = o; )
    }
};
struct EpiGate2P {
    bf16_t* O; const bf16_t* gate;
    __device__ __forceinline__ void mid(f32x4 (&acc)[2][2][4][2], const Unit& u, int wr, int wc, int fr, int fq) const {
        const int row0 = u.pm * BM + wr * 64 + fr, col8 = u.pn * BM + wc * 32 + 8 * fq;
#pragma unroll
        for (int ai = 0; ai < 2; ++ai)
#pragma unroll
            for (int m = 0; m < 4; ++m) { const bf16_t* gp = gate + (size_t)(row0 + ai * HALF + m * 16) * LDP + col8;
#pragma unroll
                for (int bj = 0; bj < 2; ++bj) { float gc[8], gr[8]; unpack8(*(const uint4*)(gp + C_GC + bj * HALF), gc); unpack8(*(const uint4*)(gp + C_GR + bj * HALF), gr);
#pragma unroll
                    for (int e = 0; e < 4; ++e) { acc[ai][bj][m][0][e] *= sigmoidf_(gc[e]) * (1.0f + __expf(-fminf(fmaxf(gr[e], -30.f), 30.f)));
                        acc[ai][bj][m][1][e] *= sigmoidf_(gc[4 + e]) * (1.0f + __expf(-fminf(fmaxf(gr[4 + e], -30.f), 30.f))); } } }
    }
    __device__ __forceinline__ void operator()(const f32x4 (&acc)[2][2][4][2], const Unit& u, int wr, int wc, int fr, int fq) const {
        EPIP_ROWS( float gr[8]; unpack8(*(const uint4*)(gate + row * LDP + C_GR + col8 + co), gr); float o[8];
            _Pragma("unroll") for (int e = 0; e < 4; ++e) { o[e] = sigmoidf_(fminf(fmaxf(gr[e], -30.f), 30.f)) * v0[e]; o[4 + e] = sigmoidf_(fminf(fmaxf(gr[4 + e], -30.f), 30.f)) * v1[e]; }
            *(uint4*)(O + row * DM + col8 + co) = pack8(o); )
    }
};
struct EpiSigMulP {
    bf16_t* O; const bf16_t* pp;
    __device__ __forceinline__ void operator()(const f32x4 (&acc)[2][2][4][2], const Unit& u, int wr, int wc, int fr, int fq) const {
        EPIP_ROWS( float pq[8]; unpack8(*(const uint4*)(pp + row * DM + col8 + co), pq); float o[8];
            _Pragma("unroll") for (int e = 0; e < 4; ++e) { o[e] = sigmoidf_(v0[e]) * pq[e]; o[4 + e] = sigmoidf_(v1[e]) * pq[4 + e]; }
            *(uint4*)(O + row * DM + col8 + co) = pack8(o); )
    }
};
struct EpiLora {
    KP kp; int l;
    __device__ __forceinline__ void operator()(const f32x4 (&acc)[2][2][4][2], const Unit& u, int wr, int wc, int fr, int fq) const {
        unsigned char* ws = kp->ws;
        if (u.pn >= 8) { EpiBf16P e{(bf16_t*)(ws + OFF_GG) - 2048, 512}; e(acc, u, wr, wc, fr, fq); return; }
        const int d = u.pn >> 2; const unsigned c = (unsigned)(128 * (u.pn & 3) + wc * 32 + 8 * fq);
        const float* w0p = kp->in[14] + (size_t)(l * 2 + d) * 512 + c; const float* a0p = kp->in[16] + (size_t)(l * 2 + d) * 512 + c;
        const f32x4 w0a = *(const f32x4*)(w0p), w0b = *(const f32x4*)(w0p + 4), a0a = *(const f32x4*)(a0p), a0b = *(const f32x4*)(a0p + 4);
        const unsigned row0 = (unsigned)(u.pm * BM + wr * 64 + fr);
#pragma unroll
        for (int ai = 0; ai < 2; ++ai)
#pragma unroll
            for (int m = 0; m < 4; ++m) { const unsigned row = row0 + (unsigned)(ai * HALF + m * 16);
                const f32x4 l0 = acc[ai][0][m][0] + w0a, l1 = acc[ai][0][m][1] + w0b, p0 = acc[ai][1][m][0] + a0a, p1 = acc[ai][1][m][1] + a0b;
                const unsigned d2 = (((unsigned)d * TCH + row) * 512u + c) * 2u;
                uint4 o; o.x = pack2(l0[0], l0[1]); o.y = pack2(l0[2], l0[3]); o.z = pack2(l1[0], l1[1]); o.w = pack2(l1[2], l1[3]); *(uint4*)(ws + (unsigned)OFF_S + d2) = o;
                o.x = pack2(p0[0], p0[1]); o.y = pack2(p0[2], p0[3]); o.z = pack2(p1[0], p1[1]); o.w = pack2(p1[2], p1[3]); *(uint4*)(ws + (unsigned)(OFF_S + 128 * MiB) + d2) = o; }
    }
};
struct EpiAny {
    KP kp; int s, l, L;
    __device__ __forceinline__ bool has_mid() const { return s == 6; }
    __device__ __forceinline__ void mid(f32x4 (&acc)[2][2][4][2], const Unit& u, int wr, int wc, int fr, int fq) const {
        unsigned char* ws = kp->ws; EpiGate2P e{(bf16_t*)(ws + OFF_U), (const bf16_t*)(ws + OFF_P)}; e.mid(acc, u, wr, wc, fr, fq); }
    __device__ __forceinline__ void operator()(const f32x4 (&acc)[2][2][4][2], const Unit& u, int wr, int wc, int fr, int fq) const {
        unsigned char* ws = kp->ws;
        bf16_t* RU = (bf16_t*)(ws + OFF_U); bf16_t* RP = (bf16_t*)(ws + OFF_P); bf16_t* MF = (bf16_t*)(ws + OFF_M);
        if (s == 1) { EpiBf16P e{RP, LDP}; e(acc, u, wr, wc, fr, fq); }
        else if (s == 10) { EpiFfn e{kp, l, L}; e(acc, u, wr, wc, fr, fq); }
        else if (s == 3) { EpiLora e{kp, l}; e(acc, u, wr, wc, fr, fq); }
        else if (s == 6) { EpiGate2P e{RU, RP}; e(acc, u, wr, wc, fr, fq); }
        else if (s == 8 || s == 12) { EpiBf16P e{MF, DM}; e(acc, u, wr, wc, fr, fq); }
        else if (s == 14) { EpiBf16P e{(bf16_t*)(ws + OFF_S + 192 * MiB), DM}; e(acc, u, wr, wc, fr, fq); }
        else { EpiSigMulP e{MF, (const bf16_t*)(ws + OFF_S + 192 * MiB)}; e(acc, u, wr, wc, fr, fq); }
    }
};
}

__device__ void phase_weights(KP p, float* tile  ) {
    bf16_t* wb = (bf16_t*)(p->ws + OFF_W);
    const int tid = o_tid(), bid = o_bid(), nblk = o_nblk();
    const int grp = tid >> 7, t128 = tid & 127, i2 = t128 >> 6, j = t128 & 63, nn = t128 >> 1, kh = (t128 & 1) * 32;
    float* tg = tile + grp * 4160;
    constexpr int TPL = 4352;
    for (int tb = bid * 4; tb < NLAYER * TPL; tb += nblk * 4) {
        const int gt = tb + grp; const bool act = gt < NLAYER * TPL;
        const int l = gt / TPL; int t = gt % TPL;
        const float* src; bf16_t* dst = wb + (size_t)l * W_LAYER; int K, N, ldd = 0; bool perm_up = false;
        if (t < 1408) { src = p->in[9] + (size_t)l * 1024 * INC; dst += W_IN; K = 1024; N = INC; }
        else if ((t -= 1408) < 128) { src = p->in[12] + (size_t)l * 512 * 1024; dst += W_A; K = 512; N = 1024; ldd = 1024; }
        else if ((t -= 128) < 128) { src = p->in[24] + (size_t)l * 512 * 1024; dst += W_A + 512; K = 512; N = 1024; ldd = 1024; }
        else if ((t -= 128) < 256) { src = p->in[25] + (size_t)l * 1024 * 1024; dst += W_OUT; K = 1024; N = 1024; }
        else if ((t -= 256) < 1408) { src = p->in[26] + (size_t)l * 1024 * 5632; dst += W_UP; K = 1024; N = 5632; perm_up = true; }
        else if ((t -= 1408) < 704) { src = p->in[29] + (size_t)l * DFF * 1024; dst += W_DOWN; K = DFF; N = 1024; }
        else if ((t -= 704) < 64) { src = p->in[30] + (size_t)l * DPLE * 1024; dst += W_PLE; K = DPLE; N = 1024; }
        else { t -= 64; src = p->in[31] + (size_t)l * 1024 * 1024; dst += W_PG; K = 1024; N = 1024; }
        const int tk = K / 64; if (ldd == 0) ldd = K;
        const int k0 = (t % tk) * 64, n0 = (t / tk) * 64, X = n0 + j;
        const int sc = perm_up ? ((X >> 4) & 1) * DFF + 128 * (X >> 8) + 64 * ((X >> 7) & 1) + 16 * ((X >> 5) & 3) + (X & 15) : X;
        float v[32];
        if (act) {
#pragma unroll
            for (int rr = 0; rr < 32; ++rr) v[rr] = (X < N) ? src[(size_t)(k0 + rr * 2 + i2) * N + sc] : 0.f;
        }
        __syncthreads();
        if (act) {
#pragma unroll
            for (int rr = 0; rr < 32; ++rr) tg[(rr * 2 + i2) * 65 + j] = v[rr];
        }
        __syncthreads();
        if (act) {
#pragma unroll
            for (int q = 0; q < 4; ++q) { float o[8];
#pragma unroll
                for (int e = 0; e < 8; ++e) o[e] = tg[(kh + 8 * q + e) * 65 + nn];
                *(uint4*)(dst + (size_t)(n0 + nn) * ldd + k0 + kh + 8 * q) = pack8(o); }
        }
    }
    __syncthreads();
    {
        bf16_t* LW = (bf16_t*)(p->ws + OFF_LORA);
        const float* dw2 = p->in[15]; const float* ia2 = p->in[17]; const float* gg2 = p->in[18];
        const int tid = o_tid(), bid = o_bid(), nblk = o_nblk();
        for (int idx = bid * 512 + tid; idx < NLAYER * (int)LORA_ELEMS; idx += nblk * 512) {
            const int l = idx / (int)LORA_ELEMS, rem = idx % (int)LORA_ELEMS, X = rem / LORA_K, k = rem % LORA_K, pn = X >> 8; float val = 0.f;
            if (pn < 8) { const int d = pn >> 2, n = (X >> 7) & 1, c = 128 * (pn & 3) + (X & 127), kk_ = k - 128 * d - 64 * n;
                if (kk_ >= 0 && kk_ < 64) val = n ? ia2[((size_t)(l * 2 + d) * 64 + kk_) * 512 + c] : dw2[((size_t)(l * 2 + d) * 64 + kk_) * 512 + c]; }
            else { const int cgc = X - 2048, kk_ = k - 256; if (kk_ >= 0) val = gg2[((size_t)l * 128 + kk_) * 512 + cgc]; }
            LW[idx] = f2bf(val);
        }
    }
}

__device__ void phase_rows(int flags, const float* xin, bf16_t* XB, const bf16_t* mf, const float* g1, const float* g2, float* xout, bf16_t* U,
                           const float* pin, bf16_t* Pb) {
    const int tid = o_tid(), wave = tid >> 6, lane = tid & 63; const int bid = o_bid(), nblk = o_nblk();
    const int stride = nblk * 8;
    for (int r0 = bid * 8 + wave; r0 < TCH; r0 += 2 * stride) {
        float4 x[2][4]; uint2 mq[2][4]; float4 pv[2];
#pragma unroll
        for (int k = 0; k < 2; ++k) { const int r = r0 + k * stride; if (r < TCH) {
            if (flags & 16) { const uint2* xr = (const uint2*)(XB + (size_t)r * DM);
#pragma unroll
                for (int i = 0; i < 4; ++i) { const uint2 q = xr[lane + 64 * i]; x[k][i] = make_float4(bflo(q.x), bfhi(q.x), bflo(q.y), bfhi(q.y)); } }
            else { const float4* xr = (const float4*)(xin + (size_t)r * DM);
#pragma unroll
                for (int i = 0; i < 4; ++i) x[k][i] = xr[lane + 64 * i]; }
            if (flags & 1) { const uint2* mr = (const uint2*)(mf + (size_t)r * DM);
#pragma unroll
                for (int i = 0; i < 4; ++i) { const unsigned long long t64 = __builtin_nontemporal_load((const unsigned long long*)(mr + lane + 64 * i)); mq[k][i] = make_uint2((unsigned)t64, (unsigned)(t64 >> 32)); } }
            if (flags & 8) pv[k] = ((const float4*)(pin + (size_t)r * DPLE))[lane]; } }
#pragma unroll
        for (int k = 0; k < 2; ++k) { const int r = r0 + k * stride; if (r < TCH) {
            if (flags & 1) {
                float ss = 0.f; float4 m[4];
#pragma unroll
                for (int i = 0; i < 4; ++i) { m[i] = make_float4(bflo(mq[k][i].x), bfhi(mq[k][i].x), bflo(mq[k][i].y), bfhi(mq[k][i].y)); ss += m[i].x * m[i].x + m[i].y * m[i].y + m[i].z * m[i].z + m[i].w * m[i].w; }
                ss = wave_sum(ss); const float rs = rsqrtf(ss * (1.0f / DM) + 1e-6f);
#pragma unroll
                for (int i = 0; i < 4; ++i) { const float4 g = ((const float4*)g1)[lane + 64 * i];
                    x[k][i].x += m[i].x * rs * g.x; x[k][i].y += m[i].y * rs * g.y; x[k][i].z += m[i].z * rs * g.z; x[k][i].w += m[i].w * rs * g.w; }
                if (flags & 32) { float4* xo = (float4*)(xout + (size_t)r * DM);
#pragma unroll
                    for (int i = 0; i < 4; ++i) __builtin_nontemporal_store((f32x4){x[k][i].x, x[k][i].y, x[k][i].z, x[k][i].w}, (f32x4*)(xo + lane + 64 * i)); }
                else { uint2* xo = (uint2*)(XB + (size_t)r * DM);
#pragma unroll
                    for (int i = 0; i < 4; ++i) { uint2 o; o.x = pack2(x[k][i].x, x[k][i].y); o.y = pack2(x[k][i].z, x[k][i].w); xo[lane + 64 * i] = o; } }
            }
            if (flags & 8) { uint2 o; o.x = pack2(pv[k].x, pv[k].y); o.y = pack2(pv[k].z, pv[k].w); ((uint2*)(Pb + (size_t)r * DPLE))[lane] = o; }
            if (flags & 2) {
                float ss = 0.f;
#pragma unroll
                for (int i = 0; i < 4; ++i) ss += x[k][i].x * x[k][i].x + x[k][i].y * x[k][i].y + x[k][i].z * x[k][i].z + x[k][i].w * x[k][i].w;
                ss = wave_sum(ss); const float rs2 = rsqrtf(ss * (1.0f / DM) + 1e-6f);
                uint2* uo = (uint2*)(U + (size_t)r * DM);
#pragma unroll
                for (int i = 0; i < 4; ++i) { const float4 g = ((const float4*)g2)[lane + 64 * i];
                    uint2 o; o.x = pack2(x[k][i].x * rs2 * g.x, x[k][i].y * rs2 * g.y); o.y = pack2(x[k][i].z * rs2 * g.z, x[k][i].w * rs2 * g.w); uo[lane + 64 * i] = o; }
            } } }
    }
}

__device__ void phase_prep_ew(KP p, int l, int L, const bf16_t* __restrict__ PROJ, bf16_t* __restrict__ G, bf16_t* KK, bf16_t* __restrict__ ZT) {
    const int tid = o_tid(), wave = tid >> 6, lane = tid & 63; const int bid = o_bid(), nblk = o_nblk();
    const int c8 = lane * 8, j2 = lane * 2;
    const float* conv_w = p->in[10] + (size_t)l * 1536; const float* conv_b = p->in[11] + (size_t)l * 512;
    const float* shift_mu = p->in[13] + (size_t)l * 256; const float* k_k = p->in[19] + (size_t)l * 512;
    float cw0[8], cw1[8], cw2[8], cb[8], kkc[8];
#pragma unroll
    for (int e = 0; e < 8; ++e) { cw0[e] = conv_w[c8 + e]; cw1[e] = conv_w[512 + c8 + e]; cw2[e] = conv_w[1024 + c8 + e]; cb[e] = conv_b[c8 + e]; kkc[e] = k_k[c8 + e]; }
    const float muf0 = shift_mu[j2], muf1 = shift_mu[j2 + 1], mub0 = shift_mu[128 + j2], mub1 = shift_mu[128 + j2 + 1];
#pragma unroll 2
    for (int r = bid * 8 + wave; r < TCH; r += nblk * 8) {
        const int pos = r & (L - 1); const bool hp = pos > 0, hn = pos < L - 1;
        const bf16_t* pr = PROJ + (size_t)r * LDP;
        const uint4 z4 = make_uint4(0, 0, 0, 0);
        const uint4 hc_c = *(const uint4*)(pr + C_HC + c8), cg_c = *(const uint4*)(pr + C_CG + c8), bgq = *(const uint4*)(pr + C_BG + c8), kq = *(const uint4*)(pr + C_K + c8);
        uint4 hc_p = z4, cg_p = z4, hc_n = z4, cg_n = z4; unsigned zf_p = 0, zb_n = 0;
        const unsigned zf_c = *(const unsigned*)(pr + C_ZF + j2), zb_c = *(const unsigned*)(pr + C_ZB + j2), gd_c = *(const unsigned*)(pr + C_GD + j2);
        if (hp) { hc_p = *(const uint4*)(pr - LDP + C_HC + c8); cg_p = *(const uint4*)(pr - LDP + C_CG + c8); zf_p = *(const unsigned*)(pr - LDP + C_ZF + j2); }
        if (hn) { hc_n = *(const uint4*)(pr + LDP + C_HC + c8); cg_n = *(const uint4*)(pr + LDP + C_CG + c8); zb_n = *(const unsigned*)(pr + LDP + C_ZB + j2); }
        float a[8], b[8], chp[8], chc[8], chn[8], o[8];
        unpack8(hc_p, a); unpack8(cg_p, b);
#pragma unroll
        for (int e = 0; e < 8; ++e) chp[e] = a[e] * b[e];
        unpack8(hc_c, a); unpack8(cg_c, b);
#pragma unroll
        for (int e = 0; e < 8; ++e) chc[e] = a[e] * b[e];
        unpack8(hc_n, a); unpack8(cg_n, b);
#pragma unroll
        for (int e = 0; e < 8; ++e) chn[e] = a[e] * b[e];
        unpack8(bgq, a);
#pragma unroll
        for (int e = 0; e < 8; ++e) o[e] = a[e] * (cw0[e] * chp[e] + cw1[e] * chc[e] + cw2[e] * chn[e] + cb[e]);
        *(uint4*)(G + (size_t)r * 1024 + c8) = pack8(o);
        { float m0 = bflo(zf_c), m1 = bfhi(zf_c); m0 += muf0 * (bflo(zf_p) - m0); m1 += muf1 * (bfhi(zf_p) - m1);
          if (lane < 32) { m0 = tanhf(m0); m1 = tanhf(m1); }
          float n0 = bflo(zb_c), n1 = bfhi(zb_c); n0 += mub0 * (bflo(zb_n) - n0); n1 += mub1 * (bfhi(zb_n) - n1);
          if (lane < 32) { n0 = tanhf(n0); n1 = tanhf(n1); }
          bf16_t* zr = ZT + (size_t)r * LORA_K;
          *(unsigned*)(zr + j2) = pack2(m0, m1); *(unsigned*)(zr + 128 + j2) = pack2(n0, n1);
          *(unsigned*)(zr + 256 + j2) = pack2(sigmoidf_(bflo(gd_c)), sigmoidf_(bfhi(gd_c))); }
    }
}

typedef float f32x2 __attribute__((ext_vector_type(2)));
struct ScanOps { f32x4 w[2], kk[2]; f32x2 v; };
__device__ __forceinline__ void scan_ld(const float* ob, const float* obv, int i, ScanOps& o) {
    const float* oi = ob + i * 64;
#pragma unroll
    for (int j4 = 0; j4 < 2; ++j4) { o.kk[j4] = *(const f32x4*)(oi + 1024 + 4 * j4); o.w[j4] = *(const f32x4*)(oi + 4 * j4); }
    o.v = *(const f32x2*)(obv + i * 64);
}
__device__ __forceinline__ void scan_rows(f32x2 (&X)[8], const ScanOps& o, const f32x4 (&b)[2], const f32x4 (&kd)[2], const f32x4 (&r)[2], const bool use_v, float& yA, float& yB) {
    f32x2 aA = X[0] * o.kk[0].xy, aB = X[4] * o.kk[0].xy;
    aA += X[1] * o.kk[0].zw; aB += X[5] * o.kk[0].zw;
    aA += X[2] * o.kk[1].xy; aB += X[6] * o.kk[1].xy;
    aA += X[3] * o.kk[1].zw; aB += X[7] * o.kk[1].zw;
    const float saA = sum8(aA.x + aA.y), saB = sum8(aB.x + aB.y);
    const f32x2 nA = (f32x2){-saA, -saA}, nB = (f32x2){-saB, -saB}, vA = (f32x2){o.v.x, o.v.x}, vB = (f32x2){o.v.y, o.v.y};
    f32x2 tA, tB, accA, accB;
    tA = X[0] * o.w[0].xy; tA += nA * b[0].xy; if (use_v) tA += vA * kd[0].xy; X[0] = tA; accA = tA * r[0].xy;
    tB = X[4] * o.w[0].xy; tB += nB * b[0].xy; if (use_v) tB += vB * kd[0].xy; X[4] = tB; accB = tB * r[0].xy;
    tA = X[1] * o.w[0].zw; tA += nA * b[0].zw; if (use_v) tA += vA * kd[0].zw; X[1] = tA; accA += tA * r[0].zw;
    tB = X[5] * o.w[0].zw; tB += nB * b[0].zw; if (use_v) tB += vB * kd[0].zw; X[5] = tB; accB += tB * r[0].zw;
    tA = X[2] * o.w[1].xy; tA += nA * b[1].xy; if (use_v) tA += vA * kd[1].xy; X[2] = tA; accA += tA * r[1].xy;
    tB = X[6] * o.w[1].xy; tB += nB * b[1].xy; if (use_v) tB += vB * kd[1].xy; X[6] = tB; accB += tB * r[1].xy;
    tA = X[3] * o.w[1].zw; tA += nA * b[1].zw; if (use_v) tA += vA * kd[1].zw; X[3] = tA; accA += tA * r[1].zw;
    tB = X[7] * o.w[1].zw; tB += nB * b[1].zw; if (use_v) tB += vB * kd[1].zw; X[7] = tB; accB += tB * r[1].zw;
    yA = sum8(accA.x + accA.y); yB = sum8(accB.x + accB.y);
}
__device__ __forceinline__ void scan_step1(f32x2 (&X)[8], const ScanOps& o, const float* oi, float& yA, float& yB) {
    f32x4 b[2], kd[2], r[2];
#pragma unroll
    for (int j4 = 0; j4 < 2; ++j4) { b[j4] = *(const f32x4*)(oi + 2048 + 4 * j4); kd[j4] = *(const f32x4*)(oi + 3072 + 4 * j4); r[j4] = *(const f32x4*)(oi + 4096 + 4 * j4); }
    scan_rows(X, o, b, kd, r, true, yA, yB);
}
__device__ __forceinline__ void scan_step2(f32x2 (&S2)[8], f32x2 (&P2)[8], const ScanOps& o, const float* oi, const bool hasP, float& ysA, float& ysB, float& yqA, float& yqB) {
    f32x4 b[2], kd[2], r[2];
#pragma unroll
    for (int j4 = 0; j4 < 2; ++j4) { b[j4] = *(const f32x4*)(oi + 2048 + 4 * j4); kd[j4] = *(const f32x4*)(oi + 3072 + 4 * j4); r[j4] = *(const f32x4*)(oi + 4096 + 4 * j4); }
    scan_rows(S2, o, b, kd, r, true, ysA, ysB);
    if (hasP) scan_rows(P2, o, b, kd, r, false, yqA, yqB);
}
__device__ void phase_scan(int c, const bf16_t* PROJ, const float* k_k, const bf16_t* Wd, const bf16_t* Bd, const float* k_a, bf16_t* Y, bf16_t* Q, float* FS, float* sm) {
    const int L = (c == 0) ? 8192 : 2048;
    const int nunit = 256;
    const int bid = o_bid(), nblk = o_nblk();
    const int tid = o_tid(), ub = tid >> 8, tu = tid & 255, wq = tu >> 6, lane = tu & 63, q = lane & 7, vp = lane >> 3;
    float* opb = sm;
    float* ybw = sm + 12288 + wq * 256;
    float* qbw = sm + 13312 + wq * 256;
    const int ild = tu >> 4, k4 = (tu & 15) * 4;
    const int nch = 128;
    for (int u = bid; u < nunit; u += nblk) {
        const bool roleP = (ub == 1), ldr = (ub == 1);
        const int base = (c == 0) ? (u >> 2) : u, j = (c == 0) ? (u & 3) : 0; const bool hasP = j > 0; const int g0 = 2048 * j;
        const int dir = base & 1, h = (base >> 1) & 7, seq = base >> 4;
        const size_t hc = (size_t)h * 64 + k4;
        const bool act = !roleP || hasP;
        f32x2 X[8];
#pragma unroll
        for (int jj = 0; jj < 8; ++jj) { const int rw = 16 * wq + 2 * vp + (jj >> 2), kx = 8 * q + 2 * (jj & 3);
            X[jj].x = (roleP && kx == rw) ? 1.f : 0.f; X[jj].y = (roleP && kx + 1 == rw) ? 1.f : 0.f; }
        float* obw = roleP ? qbw : ybw; bf16_t* gout = roleP ? Q : Y;
        f32x4 pw = (f32x4){0.f, 0.f, 0.f, 0.f}; uint2 pkk = make_uint2(0, 0), pb = pkk, pkd = pkk, pr = pkk, pv = pkk;
        const f32x4 ka4 = *(const f32x4*)(k_a + hc), kk4 = *(const f32x4*)(k_k + hc);
        auto issue = [&](int ci) {
            const int g = g0 + ci * 16 + ild; const int t = dir ? (L - 1 - g) : g;
            const size_t row = (size_t)seq * L + t;
            { const uint2 wq2 = *(const uint2*)(Wd + ((size_t)dir * TCH + row) * 512 + hc); pw = (f32x4){bflo(wq2.x), bfhi(wq2.x), bflo(wq2.y), bfhi(wq2.y)}; }
            pb = *(const uint2*)(Bd + ((size_t)dir * TCH + row) * 512 + hc);
            pkd = *(const uint2*)(PROJ + row * LDP + C_K + hc);
            pr = *(const uint2*)(PROJ + row * LDP + C_R + hc);
            pv = *(const uint2*)(PROJ + row * LDP + C_V + hc);
        };
        auto stash = [&](int buf) {
            float* o = opb + buf * 6144 + ild * 64 + k4;
            const float ap[4] = {bflo(pb.x), bfhi(pb.x), bflo(pb.y), bfhi(pb.y)}, kv[4] = {bflo(pkd.x), bfhi(pkd.x), bflo(pkd.y), bfhi(pkd.y)};
            float kkv[4]; float ss = 0.f;
#pragma unroll
            for (int e = 0; e < 4; ++e) { kkv[e] = kv[e] * kk4[e]; ss += kkv[e] * kkv[e]; }
            ss = sum16(ss); const float rn = 1.0f / fmaxf(sqrtf(ss), 1e-12f);
#pragma unroll
            for (int e = 0; e < 4; ++e) kkv[e] *= rn;
            f32x4 wv, bv, kdv;
#pragma unroll
            for (int e = 0; e < 4; ++e) { const float zz = -pw[e]; const float sp = fmaxf(zz, 0.f) + __logf(1.0f + __expf(-fabsf(zz)));
                wv[e] = __expf(-__expf(-sp - 0.5f)); const float a = sigmoidf_(ap[e]); bv[e] = kkv[e] * a; kdv[e] = kv[e] * (1.0f + (a - 1.0f) * ka4[e]); }
            *(f32x4*)(o) = wv;
            *(f32x4*)(o + 1024) = (f32x4){kkv[0], kkv[1], kkv[2], kkv[3]};
            *(f32x4*)(o + 2048) = bv;
            *(f32x4*)(o + 3072) = kdv;
            *(f32x4*)(o + 4096) = (f32x4){bflo(pr.x), bfhi(pr.x), bflo(pr.y), bfhi(pr.y)};
            *(f32x4*)(o + 5120) = (f32x4){bflo(pv.x), bfhi(pv.x), bflo(pv.y), bfhi(pv.y)};
        };
        __syncthreads();
        if (ldr) { issue(0); stash(0); issue(1); }
        __syncthreads();
        for (int ci = 0; ci < nch; ++ci) {
            if (ldr && ci + 1 < nch) { stash((ci + 1) & 1); if (ci + 2 < nch) issue(ci + 2); }
            if (act) {
                const float* ob = opb + (ci & 1) * 6144 + q * 8;
                const float* obv = opb + (ci & 1) * 6144 + 5120 + wq * 16 + 2 * vp;
                ScanOps A, B;
                scan_ld(ob, obv, 0, A);
#pragma unroll
                for (int i = 0; i < 16; i += 2) {
                    float yA = 0.f, yB = 0.f;
                    scan_ld(ob, obv, i + 1, B);
                    if (roleP) A.v = (f32x2){0.f, 0.f};
                    scan_step1(X, A, ob + i * 64, yA, yB);
                    *(f32x2*)(obw + i * 16 + 2 * vp) = (f32x2){yA, yB};
                    if (i + 2 < 16) scan_ld(ob, obv, i + 2, A);
                    if (roleP) B.v = (f32x2){0.f, 0.f};
                    scan_step1(X, B, ob + (i + 1) * 64, yA, yB);
                    *(f32x2*)(obw + (i + 1) * 16 + 2 * vp) = (f32x2){yA, yB};
                }
                __builtin_amdgcn_wave_barrier(); asm volatile("s_waitcnt lgkmcnt(0)" ::: "memory");
                { const int st = lane >> 2, v4 = (lane & 3) * 4;
                  const int g = g0 + ci * 16 + st; const int t = dir ? (L - 1 - g) : g;
                  const size_t o = ((size_t)dir * TCH + (size_t)seq * L + t) * 512 + h * 64 + wq * 16 + v4;
                  const f32x4 yv = *(const f32x4*)(obw + st * 16 + v4);
                  uint2 pk; pk.x = pack2(yv[0], yv[1]); pk.y = pack2(yv[2], yv[3]); *(uint2*)(gout + o) = pk; }
                __builtin_amdgcn_wave_barrier();
            }
            __syncthreads();
        }
        if (act && c == 0) {
            float* fs = FS + ((size_t)(base * 7 + (roleP ? 3 + j : j)) * 64 + wq * 16 + 2 * vp) * 64 + q * 8;
            *(f32x4*)(fs) = (f32x4){X[0].x, X[0].y, X[1].x, X[1].y}; *(f32x4*)(fs + 4) = (f32x4){X[2].x, X[2].y, X[3].x, X[3].y};
            *(f32x4*)(fs + 64) = (f32x4){X[4].x, X[4].y, X[5].x, X[5].y}; *(f32x4*)(fs + 68) = (f32x4){X[6].x, X[6].y, X[7].x, X[7].y};
        }
    }
}

__device__ void phase_fixup(const float* FS, const bf16_t* Q, bf16_t* Y, float* sm) {
    const int L = 8192;
    const int tid = o_tid(), bid = o_bid(), nblk = o_nblk();
    float* A = sm; float* B = sm + 4160; float* qs = sm + 8320;
    for (int item = bid; item < 192; item += nblk) {
        const int base = item / 3, j = item % 3 + 1;
        const int dir = base & 1, h = (base >> 1) & 7, seq = base >> 4;
        const float* SL = FS + (size_t)(base * 7) * 4096; const float* PF = FS + (size_t)(base * 7 + 3) * 4096;
        __syncthreads();
        for (int idx = tid; idx < 4096; idx += 512) A[(idx >> 6) * 65 + (idx & 63)] = SL[idx];
        __syncthreads();
        float* cur = A; float* nxt = B;
        for (int jj = 1; jj < j; ++jj) {
            const int v = tid >> 3, kc = (tid & 7) * 8;
            const float* P = PF + (size_t)jj * 4096 + kc;
            f32x4 a0 = *(const f32x4*)(SL + (size_t)jj * 4096 + v * 64 + kc), a1 = *(const f32x4*)(SL + (size_t)jj * 4096 + v * 64 + kc + 4);
            for (int m = 0; m < 64; ++m) { const float cv = cur[v * 65 + m]; a0 += cv * *(const f32x4*)(P + m * 64); a1 += cv * *(const f32x4*)(P + m * 64 + 4); }
#pragma unroll
            for (int e = 0; e < 4; ++e) { nxt[v * 65 + kc + e] = a0[e]; nxt[v * 65 + kc + 4 + e] = a1[e]; }
            __syncthreads();
            float* tsw = cur; cur = nxt; nxt = tsw;
        }
        const int v = tid & 63, tg = tid >> 6;
        float s0[64];
#pragma unroll
        for (int m = 0; m < 64; ++m) s0[m] = cur[v * 65 + m];
        float* qw = qs + tg * 64;
        for (int sg = tg; sg < 2048; sg += 8) {
            const int g = 2048 * j + sg; const int t = dir ? (L - 1 - g) : g;
            const size_t o = ((size_t)dir * TCH + (size_t)seq * L + t) * 512 + h * 64 + v;
            qw[v] = bf2f(Q[o]);
            __builtin_amdgcn_wave_barrier(); asm volatile("s_waitcnt lgkmcnt(0)" ::: "memory");
            float acc = 0.f;
#pragma unroll
            for (int m4 = 0; m4 < 16; ++m4) { const f32x4 qq = *(const f32x4*)(qw + 4 * m4); acc += s0[4 * m4] * qq[0] + s0[4 * m4 + 1] * qq[1] + s0[4 * m4 + 2] * qq[2] + s0[4 * m4 + 3] * qq[3]; }
            __builtin_amdgcn_wave_barrier();
            Y[o] = f2bf(bf2f(Y[o]) + acc);
        }
    }
}

__device__ void phase_post(KP p, int l, const bf16_t* __restrict__ PROJ, const bf16_t* __restrict__ Y, const bf16_t* __restrict__ GG, bf16_t* __restrict__ OB) {
    const int tid = o_tid(), wave = tid >> 6, lane = tid & 63; const int bid = o_bid(), nblk = o_nblk();
    const int c8 = lane * 8;
    float rk[8], gnw[8], gnb[8];
#pragma unroll
    for (int e = 0; e < 8; ++e) { rk[e] = p->in[21][l * 512 + c8 + e]; gnw[e] = p->in[22][l * 512 + c8 + e]; gnb[e] = p->in[23][l * 512 + c8 + e]; }
#pragma unroll 2
    for (int r = bid * 8 + wave; r < TCH; r += nblk * 8) {
        const uint4 yfq = *(const uint4*)(Y + (size_t)r * 512 + c8), ybq = *(const uint4*)(Y + ((size_t)TCH + r) * 512 + c8);
        const bf16_t* pr = PROJ + (size_t)r * LDP;
        const uint4 rq = *(const uint4*)(pr + C_R + c8), kq = *(const uint4*)(pr + C_K + c8), vq = *(const uint4*)(pr + C_V + c8), gq = *(const uint4*)(GG + (size_t)r * 512 + c8);
        float y[8], rr[8], kk[8], vv[8], g[8], o[8];
#pragma unroll
        for (int e = 0; e < 4; ++e) { y[e] = 0.f; y[4 + e] = 0.f; }
        { float ya[8], yb8[8]; unpack8(yfq, ya); unpack8(ybq, yb8);
#pragma unroll
          for (int e = 0; e < 8; ++e) y[e] = ya[e] + yb8[e]; }
        float s = 0.f;
#pragma unroll
        for (int e = 0; e < 8; ++e) s += y[e];
        const float mean = sum8(s) * (1.0f / 64.0f);
        float s2 = 0.f;
#pragma unroll
        for (int e = 0; e < 8; ++e) { y[e] -= mean; s2 += y[e] * y[e]; }
        const float rstd = rsqrtf(sum8(s2) * (1.0f / 64.0f) + 64e-5f);
        unpack8(rq, rr); unpack8(kq, kk); unpack8(vq, vv); unpack8(gq, g);
        float bs = 0.f;
#pragma unroll
        for (int e = 0; e < 8; ++e) bs += rr[e] * kk[e] * rk[e];
        bs = sum8(bs);
#pragma unroll
        for (int e = 0; e < 8; ++e) o[e] = (y[e] * rstd * gnw[e] + gnb[e] + bs * vv[e]) * g[e];
        *(uint4*)(OB + (size_t)r * 1024 + 512 + c8) = pack8(o);
    }
}

constexpr int NPH0 = 15 + 14, NPHX = 14 + 13;
__device__ __forceinline__ int sub_of(int idx) { return idx + (idx >= 7) + (idx >= 10) + (idx >= 12); }
__device__ __forceinline__ void run_phase(KP p, int ph, unsigned char* shm) {
    float* smf = (float*)shm;
    if (ph == 0) { phase_weights(p, smf); return; }
    int q = ph - 1, c, l, s;
    if (q < NPH0) { c = 0; l = q >= 15; int idx = l ? q - 15 + 1 : q; s = (idx <= 4) ? idx : (idx == 5 ? 17 : sub_of(idx - 1)); }
    else { q -= NPH0; c = 1 + q / NPHX; q %= NPHX; l = q >= 14; s = sub_of(l ? q - 14 + 1 : q); }
    const int L = (c == 0) ? 8192 : 2048;
    unsigned char* ws = p->ws;
    using namespace pg8;
    const bool is_gemm = (s == 1) | (s == 3) | (s == 6) | (s == 8) | (s == 10) | (s == 12) | (s == 15);
    if (is_gemm) {
        const bf16_t* wl = (const bf16_t*)(ws + OFF_W) + (size_t)l * W_LAYER;
        bf16_t* RU = (bf16_t*)(ws + OFF_U);
        const int ng = (s == 12) ? 2 : 1;
        for (int gi = 0; gi < ng; ++gi) {
            const int se = (gi == 0) ? s : 14;
            Gemm g;
            switch (se) {
            case 1: g = Gemm{RU, wl + W_IN, DM, DM, TCH / 256, LDP, DM, 0, 1}; break;
            case 3: g = Gemm{(bf16_t*)(ws + OFF_ZT), (const bf16_t*)(ws + OFF_LORA) + (size_t)l * LORA_ELEMS, LORA_K, LORA_K, TCH / 256, LORA_N, LORA_K, 0, 1}; break;
            case 6: g = Gemm{(bf16_t*)(ws + OFF_M), wl + W_A, DM, DM, TCH / 256, DM, 512, 2, 1}; break;
            case 8: g = Gemm{RU, wl + W_OUT, DM, DM, TCH / 256, DM, DM, 0, 1}; break;
            case 10: g = Gemm{RU - DM, wl + W_UP, DM, DM, (TCH + 247) / 248, LDP, DM, 1, 0}; break;
            case 12: g = Gemm{(bf16_t*)(ws + OFF_S), wl + W_DOWN, DFF, DFF, TCH / 256, DM, DFF, 0, 1}; break;
            case 14: g = Gemm{(bf16_t*)(ws + OFF_S + 176 * MiB), wl + W_PLE, DPLE, DPLE, TCH / 256, DM, DPLE, 0, 1}; break;
            default: g = Gemm{(bf16_t*)(ws + OFF_XB), wl + W_PG, DM, DM, TCH / 256, DM, DM, 0, 1}; break;
            }
            const EpiAny e{p, se, l, L};
            gemm_phase((LAS unsigned char*)shm, g, e);
        }
        return;
    }
    if (s == 2) { phase_prep_ew(p, l, L, (const bf16_t*)(ws + OFF_P), (bf16_t*)(ws + OFF_M), (bf16_t*)(ws + OFF_M + 64 * MiB), (bf16_t*)(ws + OFF_ZT)); return; }
    if (s == 4) { phase_scan(c, (const bf16_t*)(ws + OFF_P), p->in[19] + (size_t)l * 512, (const bf16_t*)(ws + OFF_S), (const bf16_t*)(ws + OFF_S + 128 * MiB),
                             p->in[20] + (size_t)l * 512, (bf16_t*)(ws + OFF_Y), (bf16_t*)(ws + OFF_S + 192 * MiB), (float*)(ws + OFF_FS), smf); return; }
    if (s == 17) { phase_fixup((const float*)(ws + OFF_FS), (const bf16_t*)(ws + OFF_S + 192 * MiB), (bf16_t*)(ws + OFF_Y), smf); return; }
    if (s == 5) { phase_post(p, l, (const bf16_t*)(ws + OFF_P), (const bf16_t*)(ws + OFF_Y), (const bf16_t*)(ws + OFF_GG), (bf16_t*)(ws + OFF_M)); return; }
    {
        float* xout = p->out + (size_t)c * TCH * DM;
        const float* x0 = (c == 0) ? p->in[0] : p->in[1] + (size_t)(c - 1) * TCH * DM;
        bf16_t* RU = (bf16_t*)(ws + OFF_U); bf16_t* XB = (bf16_t*)(ws + OFF_XB); const bf16_t* MF = (const bf16_t*)(ws + OFF_M);
        const int xsrc = (l == 0) ? 0 : 16;
        if (s == 0) phase_rows(2, x0, XB, nullptr, nullptr, p->in[4] + l * DM, nullptr, RU, nullptr, nullptr);
        else if (s == 9) { const float* pin = (c == 0) ? p->in[2] + (size_t)l * 32768 * DPLE : p->in[3] + (size_t)l * 65536 * DPLE + (size_t)(c - 1) * TCH * DPLE;
            phase_rows(1 | 2 | 8 | xsrc, x0, XB, MF, p->in[5] + l * DM, p->in[6] + l * DM, nullptr, RU, pin, (bf16_t*)(ws + OFF_S + 176 * MiB)); }
        else if (s == 13) phase_rows(1 | 16, nullptr, XB, MF, p->in[7] + l * DM, nullptr, nullptr, nullptr, nullptr, nullptr);
        else if (l == 0) phase_rows(1 | 2 | 16, nullptr, XB, MF, p->in[8] + l * DM, p->in[4] + (l + 1) * DM, nullptr, RU, nullptr, nullptr);
        else phase_rows(1 | 16 | 32, nullptr, XB, MF, p->in[8] + l * DM, nullptr, xout, nullptr, nullptr, nullptr);
    }
}

__device__ __forceinline__ void fast_barrier(unsigned* bar, unsigned target) {
    asm volatile("s_waitcnt vmcnt(0)" ::: "memory");
    __syncthreads();
    if (threadIdx.x == 0) {
        __builtin_amdgcn_fence(__ATOMIC_RELEASE, "agent");
        asm volatile("s_waitcnt vmcnt(0)" ::: "memory");
        (void)__hip_atomic_fetch_add(bar, 1u, __ATOMIC_RELAXED, __HIP_MEMORY_SCOPE_AGENT);
        unsigned spins = 0;
        while (__hip_atomic_load(bar, __ATOMIC_RELAXED, __HIP_MEMORY_SCOPE_AGENT) < target) { __builtin_amdgcn_s_sleep(1); if (++spins > (1u << 24)) break; }
        __builtin_amdgcn_fence(__ATOMIC_ACQUIRE, "agent");
        asm volatile("s_waitcnt vmcnt(0)" ::: "memory");
    }
    __syncthreads();
}

__global__ void __launch_bounds__(512, 2) fwd_megakernel(Params p, int ph_lo, int ph_hi) {
    extern __shared__ __attribute__((aligned(16))) unsigned char shm[];
    cg::grid_group grid = cg::this_grid();
    unsigned nbar = 0;
    for (int ph = ph_lo; ph < ph_hi; ++ph) {
        KP kp = (KP)__builtin_amdgcn_kernarg_segment_ptr();
        asm volatile("" : "+s"(kp));
        run_phase(kp, ph, shm);
        if (ph + 1 < ph_hi) {
            if (ph == ph_lo) grid.sync();
            else { ++nbar; fast_barrier((unsigned*)(kp->ws + OFF_BAR), nbar * gridDim.x); }
        }
    }
}

extern "C" void kernel_launch(void* const* d_in, const int* in_sizes, int n_in, void* d_out, int out_size, void* d_ws, size_t ws_size, hipStream_t stream) {
    static int grid_blocks = 0;
    if (!grid_blocks) {
        (void)hipFuncSetAttribute((const void*)fwd_megakernel, hipFuncAttributeMaxDynamicSharedMemorySize, SMEM_BYTES);
        int dev = 0, cus = 0, per_cu = 0;
        (void)hipGetDevice(&dev);
        (void)hipDeviceGetAttribute(&cus, hipDeviceAttributeMultiprocessorCount, dev);
        (void)hipOccupancyMaxActiveBlocksPerMultiprocessor(&per_cu, fwd_megakernel, 512, SMEM_BYTES);
        if (per_cu < 1) per_cu = 1;
        if (per_cu > 1) per_cu = 1;
        grid_blocks = cus * per_cu;
    }
    Params p{};
    for (int i = 0; i < 32; ++i) p.in[i] = (const float*)d_in[i];
    p.out = (float*)d_out; p.ws = (unsigned char*)d_ws;
#if ONE_LAUNCH
    (void)hipMemsetAsync((unsigned char*)d_ws + OFF_BAR, 0, 256, stream);
    int lo = 0, hi = NPH;
    void* args[] = {&p, &lo, &hi};
    hipError_t e = hipLaunchCooperativeKernel((void*)fwd_megakernel, dim3(grid_blocks), dim3(512), args, SMEM_BYTES, stream);
    if (e != hipSuccess) fprintf(stderr, "cooperative launch failed: %s (grid %d)\n", hipGetErrorString(e), grid_blocks);
#else
    for (int ph = 0; ph < NPH; ++ph) fwd_megakernel<<<grid_blocks, 512, SMEM_BYTES, stream>>>(p, ph, ph + 1);
#endif
}
```
